# Optimizing an MI355X kernel written in HIP

```python
import math
import jax, jax.numpy as jnp
from jax import lax
import numpy as np

D_MODEL = 1024
BATCH = 16
SEQ = 2048
DEPTH = 2

CTX_LEN = 256
GRID_W = 64
f32 = jnp.float32
RMS_EPS = 1e-6
ROPE_BASE = 10000.0
N_MOD = 9
D_FF = (11 * D_MODEL) // 4
MIX_W = D_MODEL
GROUP_W = MIX_W // 4

MLSTM_HEAD_DIM = 64
MLSTM_HEADS = GROUP_W // MLSTM_HEAD_DIM
MLSTM_CHUNK = 64
MLA_NOPE = 64
MLA_ROPE_DIM = 32
MLA_V = 64
MLA_HEADS = GROUP_W // MLA_V
MLA_Q_LORA = GROUP_W
MLA_KV_LORA = GROUP_W // 2
ATTN_BLK = 128
SWA_HEAD_DIM = 64
SWA_HEADS = GROUP_W // SWA_HEAD_DIM
SWA_KV_HEADS = SWA_HEADS // 2
SWA_WINDOW = 128
SWA_BLK = 128
SSD_HEAD_DIM = 64
SSD_HEADS = GROUP_W // SSD_HEAD_DIM
SSD_STATE = 64
SSD_GROUPS = 2
SSD_CONV = 5
SSD_CHUNK = 128
SSD_NORM_GROUP = GROUP_W // SSD_GROUPS
SSD_XBC = GROUP_W + 2 * SSD_GROUPS * SSD_STATE

IN_SEGMENTS = (
    ("m_q", GROUP_W), ("m_k", GROUP_W), ("m_v", GROUP_W), ("m_o", GROUP_W), ("m_gates", 4 * MLSTM_HEADS),
    ("a_q", MLA_Q_LORA), ("a_kv", MLA_KV_LORA), ("a_kr", MLA_ROPE_DIM),
    ("w_q", SWA_HEADS * SWA_HEAD_DIM), ("w_k", SWA_KV_HEADS * SWA_HEAD_DIM), ("w_v", SWA_KV_HEADS * SWA_HEAD_DIM),
    ("s_z", GROUP_W), ("s_xbc", SSD_XBC), ("s_dt", 2 * SSD_HEADS),
)
IN_COLS = sum(n for _, n in IN_SEGMENTS)

kernel_name = "hybrid_parallel_heads_diffusion_block"


def rms_norm(x, g, eps=RMS_EPS):
    xf = x.astype(f32)
    y = xf * lax.rsqrt(jnp.mean(xf * xf, axis=-1, keepdims=True) + eps)
    return (y * g.astype(f32)).astype(x.dtype)


def modulate(x, shift, scale):
    return x * (1 + scale) + shift


def swiglu(x, wi, wo):
    g, u = jnp.split(x @ wi, 2, axis=-1)
    return (jax.nn.silu(g) * u) @ wo


def split_cols(u):
    parts, o = {}, 0
    for name, n in IN_SEGMENTS:
        parts[name] = u[..., o:o + n]
        o += n
    return parts


def axial_rope(rows, rot_dim):
    row = jnp.repeat(jnp.arange(rows), GRID_W).astype(f32)
    col = jnp.tile(jnp.arange(GRID_W), rows).astype(f32)
    nf = rot_dim // 4
    inv = ROPE_BASE ** (-jnp.arange(nf, dtype=f32) / nf)
    ar, ac = row[:, None] * inv, col[:, None] * inv
    ang = jnp.concatenate([ar, ar, ac, ac], axis=-1)
    return jnp.cos(ang)[:, None, :], jnp.sin(ang)[:, None, :]


def apply_rope(x, cos, sin):
    r = x.shape[-1]
    x4 = x.reshape(x.shape[:-1] + (2, 2, r // 4))
    rot = jnp.stack([-x4[..., 1, :], x4[..., 0, :]], axis=-2).reshape(x.shape)
    return (x * cos + rot * sin).astype(x.dtype)


def to_chunks(a, L):
    b, h, t = a.shape[:3]
    return jnp.moveaxis(a.reshape((b, h, t // L, L) + a.shape[3:]), 2, 0)


def from_chunks(a):
    a = jnp.moveaxis(a, 0, 2)
    return a.reshape(a.shape[:2] + (a.shape[2] * a.shape[3],) + a.shape[4:])


def bidirectional(scan_fn, ctx_f, lat_f, ctx_b, lat_b, init):
    flip = lambda t: tuple(jnp.flip(a, axis=2) for a in t)
    h_cf, s_f = scan_fn(*ctx_f, init)
    h_lf, _ = scan_fn(*lat_f, s_f)
    h_cb, s_b = scan_fn(*flip(ctx_b), init)
    h_lb, _ = scan_fn(*flip(lat_b), s_b)
    return h_cf + jnp.flip(h_cb, axis=2), h_lf + jnp.flip(h_lb, axis=2)


def mlstm_scan(q, k, v, logi, logf, state):
    L = MLSTM_CHUNK
    tril = jnp.tril(jnp.ones((L, L), bool))

    def body(carry, inp):
        C, n, m = carry
        qc, kc, vc, ic, fc = inp
        b = jnp.cumsum(fc, axis=-1)
        D = jnp.where(tril, b[..., :, None] - b[..., None, :] + ic[..., None, :], -jnp.inf)
        m_inter = b + m[..., None]
        m_t = jnp.maximum(m_inter, jnp.max(D, axis=-1))
        w_inter = jnp.exp(m_inter - m_t)
        S = jnp.einsum('bhtd,bhsd->bhts', qc, kc) * jnp.exp(D - m_t[..., None])
        num = w_inter[..., None] * jnp.einsum('bhtd,bhde->bhte', qc, C) + jnp.einsum('bhts,bhse->bhte', S, vc)
        den = w_inter * jnp.einsum('bhtd,bhd->bht', qc, n) + jnp.sum(S, axis=-1)
        h = num / jnp.maximum(jnp.abs(den), jnp.exp(-m_t))[..., None]
        bL = b[..., -1]
        g = bL[..., None] - b + ic
        m_new = jnp.maximum(bL + m, jnp.max(g, axis=-1))
        a = jnp.exp(bL + m - m_new)
        w = jnp.exp(g - m_new[..., None])
        C_new = a[..., None, None] * C + jnp.einsum('bhs,bhsd,bhse->bhde', w, kc, vc)
        n_new = a[..., None] * n + jnp.einsum('bhs,bhsd->bhd', w, kc)
        return (C_new, n_new, m_new), h

    state, h = lax.scan(body, state, tuple(to_chunks(a, L) for a in (q, k, v, logi, logf)))
    return from_chunks(h), state


def mlstm_mixer(p_lat, p_ctx, gate_b, out_norm, need_ctx):
    H, dh = MLSTM_HEADS, MLSTM_HEAD_DIM

    def prep(p):
        b, t = p["m_q"].shape[:2]
        heads = lambda a: a.reshape(b, t, H, dh).transpose(0, 2, 1, 3).astype(f32)
        q, k, v = heads(p["m_q"]), heads(p["m_k"]) * dh ** -0.5, heads(p["m_v"])
        g = (p["m_gates"] + gate_b).astype(f32).reshape(b, t, 4, H).transpose(2, 0, 3, 1)
        return (q, k, v, g[0], jax.nn.log_sigmoid(g[1])), (q, k, v, g[2], jax.nn.log_sigmoid(g[3]))

    cf, cb = prep(p_ctx)
    lf, lb = prep(p_lat)
    b = p_lat["m_q"].shape[0]
    init = (jnp.zeros((b, H, dh, dh), f32), jnp.zeros((b, H, dh), f32), jnp.zeros((b, H), f32))
    h_c, h_l = bidirectional(mlstm_scan, cf, lf, cb, lb, init)

    def finish(h, p):
        bb, hh, t, d = h.shape
        hn = rms_norm(h.transpose(0, 2, 1, 3), out_norm.reshape(hh, d)).reshape(bb, t, hh * d)
        return (jax.nn.sigmoid(p["m_o"].astype(f32)) * hn).astype(p["m_o"].dtype)

    return finish(h_l, p_lat), (finish(h_c, p_ctx) if need_ctx else None)


def block_attention(q, k, v):
    b, t, h, dq = q.shape
    nb = t // ATTN_BLK
    scale = dq ** -0.5
    qb = q.reshape(b, nb, ATTN_BLK, h, dq).transpose(1, 0, 2, 3, 4)

    def one(qblk):
        s = jnp.einsum('bqhd,bkhd->bhqk', qblk, k).astype(f32) * scale
        p = jax.nn.softmax(s, axis=-1).astype(v.dtype)
        return jnp.einsum('bhqk,bkhd->bqhd', p, v)

    o = lax.map(one, qb)
    return o.transpose(1, 0, 2, 3, 4).reshape(b, t, h * v.shape[-1])


def mla_mixer(p_lat, p_ctx, q_norm, kv_norm, wq_b, wkv_b, q_gain, k_gain, rope, need_ctx):
    H = MLA_HEADS

    def proj(p, rope):
        b, t = p["a_q"].shape[:2]
        qh = (rms_norm(p["a_q"], q_norm) @ wq_b).reshape(b, t, H, MLA_NOPE + MLA_ROPE_DIM)
        q_nope = rms_norm(qh[..., :MLA_NOPE], q_gain[:MLA_NOPE])
        q_rope = rms_norm(qh[..., MLA_NOPE:], q_gain[MLA_NOPE:])
        kv = (rms_norm(p["a_kv"], kv_norm) @ wkv_b).reshape(b, t, H, MLA_NOPE + MLA_V)
        k_nope = rms_norm(kv[..., :MLA_NOPE], k_gain[:MLA_NOPE])
        v = kv[..., MLA_NOPE:]
        k_rope = rms_norm(p["a_kr"], k_gain[MLA_NOPE:])[:, :, None, :]
        if rope is not None:
            q_rope = apply_rope(q_rope, *rope)
            k_rope = apply_rope(k_rope, *rope)
        q = jnp.concatenate([q_nope, q_rope], axis=-1)
        k = jnp.concatenate([k_nope, jnp.broadcast_to(k_rope, (b, t, H, MLA_ROPE_DIM))], axis=-1)
        return q, k, v

    ql, kl, vl = proj(p_lat, rope)
    qc, kc, vc = proj(p_ctx, None)
    out_l = block_attention(ql, jnp.concatenate([kc, kl], axis=1), jnp.concatenate([vc, vl], axis=1))
    out_c = block_attention(qc, kc, vc) if need_ctx else None
    return out_l, out_c


def swa_mixer(p_lat, p_ctx, q_gain, k_gain, sink, rope, need_ctx):
    H, KV, dh = SWA_HEADS, SWA_KV_HEADS, SWA_HEAD_DIM
    G = H // KV
    scale = dh ** -0.5

    def proj(p, rope):
        b, t = p["w_q"].shape[:2]
        q = rms_norm(p["w_q"].reshape(b, t, H, dh), q_gain)
        k = rms_norm(p["w_k"].reshape(b, t, KV, dh), k_gain)
        v = p["w_v"].reshape(b, t, KV, dh)
        if rope is not None:
            q, k = apply_rope(q, *rope), apply_rope(k, *rope)
        return q, k, v

    ql, kl, vl = proj(p_lat, rope)
    qc, kc, vc = proj(p_ctx, None)
    b, t = ql.shape[:2]
    nb = t // SWA_BLK
    qb = ql.reshape(b, nb, SWA_BLK, KV, G, dh)

    def band(a):
        ap = jnp.pad(a, ((0, 0), (SWA_BLK, SWA_BLK), (0, 0), (0, 0))).reshape(b, nb + 2, SWA_BLK, KV, dh)
        return jnp.concatenate([ap[:, :-2], ap[:, 1:-1], ap[:, 2:]], axis=2)

    kb, vb = band(kl), band(vl)
    s_loc = jnp.einsum('bnqkgd,bnskd->bkgnqs', qb, kb).astype(f32) * scale
    blk = jnp.arange(nb)[:, None, None]
    qpos = blk * SWA_BLK + jnp.arange(SWA_BLK)[None, :, None]
    kpos = (blk - 1) * SWA_BLK + jnp.arange(3 * SWA_BLK)[None, None, :]
    valid = (kpos >= 0) & (kpos < t) & (jnp.abs(qpos - kpos) <= SWA_WINDOW)
    s_loc = jnp.where(valid, s_loc, -1e30)
    s_ctx = jnp.einsum('bnqkgd,bckd->bkgnqc', qb, kc).astype(f32) * scale
    s_sink = jnp.broadcast_to(sink.reshape(1, KV, G, 1, 1, 1).astype(f32), s_loc.shape[:-1] + (1,))
    p = jax.nn.softmax(jnp.concatenate([s_loc, s_ctx, s_sink], axis=-1), axis=-1).astype(vl.dtype)
    nl, ncx = 3 * SWA_BLK, kc.shape[1]
    o = (jnp.einsum('bkgnqs,bnskd->bnqkgd', p[..., :nl], vb)
         + jnp.einsum('bkgnqc,bckd->bnqkgd', p[..., nl:nl + ncx], vc))
    out_l = o.reshape(b, t, H * dh)
    out_c = None
    if need_ctx:
        cl = qc.shape[1]
        qg = qc.reshape(b, cl, KV, G, dh)
        s = jnp.einsum('bqkgd,bckd->bkgqc', qg, kc).astype(f32) * scale
        ss = jnp.broadcast_to(sink.reshape(1, KV, G, 1, 1).astype(f32), s.shape[:-1] + (1,))
        pc = jax.nn.softmax(jnp.concatenate([s, ss], axis=-1), axis=-1)[..., :-1].astype(vc.dtype)
        out_c = jnp.einsum('bkgqc,bckd->bqkgd', pc, vc).reshape(b, cl, H * dh)
    return out_l, out_c


def depthwise_conv(x, w, bias):
    ch = x.shape[-1]
    y = lax.conv_general_dilated(x, w[:, None, :].astype(x.dtype), window_strides=(1,),
                                 padding=[(SSD_CONV // 2, SSD_CONV // 2)],
                                 dimension_numbers=("NWC", "WIO", "NWC"), feature_group_count=ch)
    return y + bias


def ssd_scan(x, dt, a, Bm, Cm, state):
    L = SSD_CHUNK
    tril = jnp.tril(jnp.ones((L, L), bool))

    def body(S, inp):
        xc, dtc, ac, Bc, Cc = inp
        cum = jnp.cumsum(ac, axis=-1)
        seg = jnp.exp(jnp.where(tril, cum[..., :, None] - cum[..., None, :], -jnp.inf))
        w = jnp.einsum('bhtn,bhsn->bhts', Cc, Bc) * seg * dtc[..., None, :]
        y = jnp.einsum('bhts,bhsp->bhtp', w, xc) + jnp.exp(cum)[..., None] * jnp.einsum('bhtn,bhpn->bhtp', Cc, S)
        dec = jnp.exp(cum[..., -1:] - cum) * dtc
        S_new = jnp.exp(cum[..., -1])[..., None, None] * S + jnp.einsum('bhs,bhsp,bhsn->bhpn', dec, xc, Bc)
        return S_new, y

    state, y = lax.scan(body, state, tuple(to_chunks(t_, L) for t_ in (x, dt, a, Bm, Cm)))
    return from_chunks(y), state


def ssd_mixer(p_lat, p_ctx, conv_w, conv_b, dt_bias, a_log, d_skip, norm_g, need_ctx):
    H, P, N, G = SSD_HEADS, SSD_HEAD_DIM, SSD_STATE, SSD_GROUPS
    A = -jnp.exp(a_log.astype(f32)).reshape(2, H)

    def prep(p):
        b, t = p["s_xbc"].shape[:2]
        xbc = jax.nn.silu(depthwise_conv(p["s_xbc"], conv_w, conv_b)).astype(f32)
        xs, Bm, Cm = jnp.split(xbc, [GROUP_W, GROUP_W + G * N], axis=-1)
        xh = xs.reshape(b, t, H, P)
        rep = lambda m: jnp.repeat(m.reshape(b, t, G, N), H // G, axis=2).transpose(0, 2, 1, 3)
        Bh, Ch = rep(Bm), rep(Cm)
        dt = jax.nn.softplus((p["s_dt"] + dt_bias).astype(f32)).reshape(b, t, 2, H).transpose(2, 0, 3, 1)
        xt = xh.transpose(0, 2, 1, 3)
        fwd = (xt, dt[0], dt[0] * A[0][None, :, None], Bh, Ch)
        bwd = (xt, dt[1], dt[1] * A[1][None, :, None], Bh, Ch)
        return fwd, bwd, xh

    cf, cb, xc = prep(p_ctx)
    lf, lb, xl = prep(p_lat)
    b = xl.shape[0]
    init = jnp.zeros((b, H, P, N), f32)
    y_c, y_l = bidirectional(ssd_scan, cf, lf, cb, lb, init)

    def finish(y, xh, p):
        bb, t = xh.shape[:2]
        yy = (y.transpose(0, 2, 1, 3) + d_skip[:, None] * xh).reshape(bb, t, GROUP_W)
        g = (yy * jax.nn.silu(p["s_z"].astype(f32))).reshape(bb, t, GROUP_W // SSD_NORM_GROUP, SSD_NORM_GROUP)
        out = rms_norm(g, norm_g.reshape(GROUP_W // SSD_NORM_GROUP, SSD_NORM_GROUP)).reshape(bb, t, GROUP_W)
        return out.astype(p["s_z"].dtype)

    return finish(y_l, xl, p_lat), (finish(y_c, xc, p_ctx) if need_ctx else None)


def setup_inputs(seed: int = 0) -> dict:
    key = jax.random.key(seed)
    ks = iter(jax.random.split(key, 64))
    L = DEPTH

    def nrm(shape, scale=1.0):
        return jax.random.normal(next(ks), shape, f32) * scale

    def gain(shape):
        return 1.0 + nrm(shape, 0.05)

    fb = jnp.linspace(3.0, 6.0, MLSTM_HEADS, dtype=f32)
    mlstm_gate_b = jnp.concatenate([nrm((L, MLSTM_HEADS), 0.1), fb + nrm((L, MLSTM_HEADS), 0.1),
                                    nrm((L, MLSTM_HEADS), 0.1), fb + nrm((L, MLSTM_HEADS), 0.1)], axis=-1)
    dt0 = jnp.exp(jax.random.uniform(next(ks), (L, 2 * SSD_HEADS), f32, math.log(1e-3), math.log(1e-1)))
    ssd_dt_bias = dt0 + jnp.log(-jnp.expm1(-dt0))
    ssd_a_log = jnp.log(jax.random.uniform(next(ks), (L, 2 * SSD_HEADS), f32, 1.0, 16.0))
    qk_mla = MLA_NOPE + MLA_ROPE_DIM
    return {
        "x": nrm((BATCH, SEQ, D_MODEL)),
        "c": nrm((BATCH, D_MODEL)),
        "ctx": nrm((BATCH, CTX_LEN, D_MODEL)),
        "c_ctx": nrm((D_MODEL,)),
        "w_mod": nrm((L, D_MODEL, N_MOD * D_MODEL), 0.02),
        "b_mod": nrm((L, N_MOD * D_MODEL), 0.02),
        "ffn1_norm": gain((L, D_MODEL)),
        "ffn1_wi": nrm((L, D_MODEL, 2 * D_FF), D_MODEL ** -0.5),
        "ffn1_wo": nrm((L, D_FF, D_MODEL), D_FF ** -0.5),
        "mix_norm": gain((L, D_MODEL)),
        "w_in": nrm((L, D_MODEL, IN_COLS), D_MODEL ** -0.5),
        "w_out": nrm((L, MIX_W, D_MODEL), MIX_W ** -0.5),
        "mlstm_gate_b": mlstm_gate_b,
        "mlstm_out_norm": gain((L, GROUP_W)),
        "mla_q_norm": gain((L, MLA_Q_LORA)),
        "mla_kv_norm": gain((L, MLA_KV_LORA)),
        "mla_wq_b": nrm((L, MLA_Q_LORA, MLA_HEADS * qk_mla), MLA_Q_LORA ** -0.5),
        "mla_wkv_b": nrm((L, MLA_KV_LORA, MLA_HEADS * (MLA_NOPE + MLA_V)), MLA_KV_LORA ** -0.5),
        "mla_q_gain": gain((L, qk_mla)),
        "mla_k_gain": gain((L, qk_mla)),
        "swa_q_gain": gain((L, SWA_HEAD_DIM)),
        "swa_k_gain": gain((L, SWA_HEAD_DIM)),
        "swa_sink": nrm((L, SWA_HEADS), 0.5),
        "ssd_conv_w": nrm((L, SSD_CONV, SSD_XBC), SSD_CONV ** -0.5),
        "ssd_conv_b": nrm((L, SSD_XBC), 0.02),
        "ssd_dt_bias": ssd_dt_bias,
        "ssd_a_log": ssd_a_log,
        "ssd_d": 1.0 + nrm((L, SSD_HEADS), 0.1),
        "ssd_norm": gain((L, GROUP_W)),
        "ffn2_norm": gain((L, D_MODEL)),
        "ffn2_wi": nrm((L, D_MODEL, 2 * D_FF), D_MODEL ** -0.5),
        "ffn2_wo": nrm((L, D_FF, D_MODEL), D_FF ** -0.5),
    }


def reference(x, c, ctx, c_ctx, w_mod, b_mod, ffn1_norm, ffn1_wi, ffn1_wo, mix_norm, w_in, w_out,
              mlstm_gate_b, mlstm_out_norm, mla_q_norm, mla_kv_norm, mla_wq_b, mla_wkv_b, mla_q_gain,
              mla_k_gain, swa_q_gain, swa_k_gain, swa_sink, ssd_conv_w, ssd_conv_b, ssd_dt_bias, ssd_a_log,
              ssd_d, ssd_norm, ffn2_norm, ffn2_wi, ffn2_wo):
    b, t, d = x.shape
    rows = t // GRID_W
    rope_mla = axial_rope(rows, MLA_ROPE_DIM)
    rope_swa = axial_rope(rows, SWA_HEAD_DIM)
    sc, scc = jax.nn.silu(c), jax.nn.silu(c_ctx)
    h, hc = x, ctx
    for l in range(DEPTH):
        need_ctx = l < DEPTH - 1
        mod = (sc @ w_mod[l] + b_mod[l]).reshape(b, N_MOD, 1, d)
        modc = (scc @ w_mod[l] + b_mod[l]).reshape(1, N_MOD, 1, d)
        h = h + 0.5 * mod[:, 2] * swiglu(modulate(rms_norm(h, ffn1_norm[l]), mod[:, 0], mod[:, 1]),
                                         ffn1_wi[l], ffn1_wo[l])
        hc = hc + 0.5 * modc[:, 2] * swiglu(modulate(rms_norm(hc, ffn1_norm[l]), modc[:, 0], modc[:, 1]),
                                            ffn1_wi[l], ffn1_wo[l])
        u = split_cols(modulate(rms_norm(h, mix_norm[l]), mod[:, 3], mod[:, 4]) @ w_in[l])
        uc = split_cols(modulate(rms_norm(hc, mix_norm[l]), modc[:, 3], modc[:, 4]) @ w_in[l])
        a_l, a_c = mlstm_mixer(u, uc, mlstm_gate_b[l], mlstm_out_norm[l], need_ctx)
        m_l, m_c = mla_mixer(u, uc, mla_q_norm[l], mla_kv_norm[l], mla_wq_b[l], mla_wkv_b[l],
                             mla_q_gain[l], mla_k_gain[l], rope_mla, need_ctx)
        w_l, w_c = swa_mixer(u, uc, swa_q_gain[l], swa_k_gain[l], swa_sink[l], rope_swa, need_ctx)
        s_l, s_c = ssd_mixer(u, uc, ssd_conv_w[l], ssd_conv_b[l], ssd_dt_bias[l], ssd_a_log[l],
                             ssd_d[l], ssd_norm[l], need_ctx)
        h = h + mod[:, 5] * (jnp.concatenate([a_l, m_l, w_l, s_l], axis=-1) @ w_out[l])
        if need_ctx:
            hc = hc + modc[:, 5] * (jnp.concatenate([a_c, m_c, w_c, s_c], axis=-1) @ w_out[l])
            hc = hc + 0.5 * modc[:, 8] * swiglu(modulate(rms_norm(hc, ffn2_norm[l]), modc[:, 6], modc[:, 7]),
                                                ffn2_wi[l], ffn2_wo[l])
        h = h + 0.5 * mod[:, 8] * swiglu(modulate(rms_norm(h, ffn2_norm[l]), mod[:, 6], mod[:, 7]),
                                         ffn2_wi[l], ffn2_wo[l])
    return h
```

```cpp
#include <hip/hip_runtime.h>
#include <hip/hip_cooperative_groups.h>
#include <cstdio>
#include <cstdint>
namespace cg = cooperative_groups;

#define LAS __attribute__((address_space(3)))
typedef unsigned short bf16_t;
typedef short bf16x8 __attribute__((ext_vector_type(8)));
typedef float f32x4 __attribute__((ext_vector_type(4)));
typedef unsigned u32x4 __attribute__((ext_vector_type(4)));
typedef unsigned u32x2 __attribute__((ext_vector_type(2)));

#ifndef N_MIX
#define N_MIX 1
#endif

constexpr int D = 1024, NB = 16, TL = 2048, CL = 256, RL = NB * TL, RC = NB * CL, R = RL + RC;
constexpr int FF = 2816, UC = 2816, KEYS = CL + TL, NCH = KEYS / 64;
constexpr float EPS = 1e-6f;
constexpr int NTHR = 512;
constexpr int LDS_BYTES = 147456;
constexpr int UC_MQ = 0, UC_WQ = 256, UC_SZ = 512, UC_AQ = 768, UC_AKV = 1024, UC_AKR = 1152, UC_MK = 1184, UC_MV = 1440, UC_MO = 1696,
              UC_WK = 1952, UC_WV = 2080, UC_XBC = 2208, UC_MG = 2720, UC_DT = 2736;
constexpr size_t WS_HC = 0;
constexpr size_t WS_MOD = WS_HC + (size_t)RC * D * 4;
constexpr size_t WS_GATES = WS_MOD + (size_t)2 * 17 * 9216 * 4;
constexpr size_t WS_WB = WS_GATES + (size_t)R * 32 * 4;
constexpr size_t WB_WI1 = 0, WB_WO1 = WB_WI1 + (size_t)5632 * 1024 * 2, WB_WIN = WB_WO1 + (size_t)1024 * 2816 * 2, WB_WOUT = WB_WIN + (size_t)2816 * 1024 * 2,
                 WB_WI2 = WB_WOUT + (size_t)1024 * 1024 * 2, WB_WO2 = WB_WI2 + (size_t)5632 * 1024 * 2, WB_MLA = WB_WO2 + (size_t)1024 * 2816 * 2, WB_END = WB_MLA + (size_t)1024 * 384 * 2;
constexpr size_t WS_XN = WS_WB + WB_END;
constexpr size_t WS_U = WS_XN + (size_t)R * 1024 * 2;
constexpr size_t WS_STM = WS_U + (size_t)R * UC * 2;
constexpr size_t WS_STS = WS_STM + (size_t)NB * 4 * 2 * NCH * 4160 * 2;
constexpr size_t WS_DECM = WS_STS + (size_t)NB * 4 * 2 * NCH * 4096 * 2;
constexpr size_t WS_DECS = WS_DECM + (size_t)NB * 4 * 2 * NCH * 4;
constexpr size_t WS_QM = WS_DECS + (size_t)NB * 4 * 2 * NCH * 4;
constexpr size_t WS_KM = WS_QM + (size_t)NB * 4 * KEYS * 96 * 2;
constexpr size_t WS_VTM = WS_KM + (size_t)NB * 4 * KEYS * 96 * 2;
constexpr size_t WS_KS = WS_VTM + (size_t)NB * 4 * 64 * KEYS * 2;
constexpr size_t WS_VTS = WS_KS + (size_t)NB * 2 * KEYS * 64 * 2;
constexpr size_t WS_END = WS_VTS + (size_t)NB * 2 * 64 * KEYS * 2;

struct Params { const float* in[32]; float* out; unsigned char* ws; int ph_lo, ph_hi; };
enum { I_X = 0, I_C, I_CTX, I_CCTX, I_WMOD, I_BMOD, I_F1N, I_F1WI, I_F1WO, I_MIXN, I_WIN, I_WOUT, I_MGB, I_MON, I_AQN, I_AKVN, I_AWQ, I_AWKV, I_AQG, I_AKG,
       I_SQG, I_SKG, I_SINK, I_CW, I_CB, I_DTB, I_ALOG, I_SD, I_SN, I_F2N, I_F2WI, I_F2WO };

__device__ __forceinline__ float bf2f(bf16_t v) { return __uint_as_float((unsigned)v << 16); }
__device__ __forceinline__ bf16_t f2bf(float f) { unsigned u = __float_as_uint(f); return (bf16_t)((u + 0x7fffu + ((u >> 16) & 1u)) >> 16); }
__device__ __forceinline__ unsigned pk2(float lo, float hi) { return (unsigned)f2bf(lo) | ((unsigned)f2bf(hi) << 16); }
__device__ __forceinline__ float wave_sum(float v) {
#pragma unroll
    for (int o = 32; o; o >>= 1) v += __shfl_xor(v, o);
    return v;
}
__device__ __forceinline__ float siluf(float x) { return x / (1.f + __expf(-x)); }
__device__ __forceinline__ float sigmf(float x) { return 1.f / (1.f + __expf(-x)); }
__device__ __forceinline__ float logsigf(float x) { return fminf(x, 0.f) - log1pf(__expf(-fabsf(x))); }
__device__ __forceinline__ float softplusf(float x) { return fmaxf(x, 0.f) + log1pf(__expf(-fabsf(x))); }

namespace pg8 {
constexpr int BM = 256, BK = 64, HALF = 128, HTB = HALF * BK * 2, STAGE_BYTES = 8 * HTB, NXCD = 8, WGM = 8;
__host__ __device__ __forceinline__ int lds_byte(int r, int c) { const int st = (r >> 4) * 2 + (c >> 5), rr = r & 15, cc = c & 31, ob = rr * 64 + cc * 2; return st * 1024 + (ob ^ (((ob >> 9) & 1) << 5)); }
__host__ __device__ __forceinline__ void stage_rc(int b, int& Rr, int& C) { const int st = b / 1024, sb = b % 1024, swz = sb ^ (((sb >> 9) & 1) << 5); Rr = (st >> 1) * 16 + swz / 64; C = (st & 1) * 32 + (swz % 64) / 2; }
__host__ __device__ __forceinline__ int perm32(int rho) { const int n = rho >> 4, i = rho & 15; return 8 * (i >> 2) + 4 * n + (i & 3); }
struct Unit { int pm, pn; };
struct Gemm { const bf16_t* A; const bf16_t* Bt; int M, N, K, lda; };
struct StaticOrder {
    int nM, nN, nwg, G, c;
    __device__ void init(int M, int N, int G_, int c_) { nM = M / BM; nN = N / BM; nwg = nM * nN; G = G_; c = c_; }
    __device__ bool next(int i, Unit& u) const {
        const long L = (long)i * G + c; if (L >= nwg) return false;
        int wgid = (int)L; { const int q = nwg / NXCD, r = nwg % NXCD, xcd = wgid % NXCD, off = wgid / NXCD; wgid = (xcd < r ? xcd * (q + 1) : r * (q + 1) + (xcd - r) * q) + off; }
        const int nig = WGM * nN, gid = wgid / nig, fm = gid * WGM, gsz = (nM - fm) < WGM ? (nM - fm) : WGM;
        u.pm = fm + ((wgid % nig) % gsz); u.pn = (wgid % nig) / gsz; return true;
    }
};
template <class Epi>
__device__ __forceinline__ void gemm_phase(LAS unsigned char* lds, const int tid, const Gemm g, const StaticOrder& S, const Epi& E) {
    const int wid = __builtin_amdgcn_readfirstlane(tid >> 6), lane = tid & 63, wr = wid >> 2, wc = wid & 3, fr = lane & 15, fq = lane >> 4;
    const int K = g.K, nt = K / BK, lda = g.lda;
    unsigned voffA_, voffB_;
    { int Rr, C; stage_rc(tid * 16, Rr, C); const int Rb = Epi::PERM ? ((Rr & ~31) + perm32(Rr & 31)) : Rr;
      voffA_ = (unsigned)(Rr * lda + C) * 2u; voffB_ = (unsigned)(Rb * K + C) * 2u; }
    const unsigned v_offA = voffA_, v_offB = voffB_;
    const size_t r64offA = (size_t)64 * lda * 2, r64offB = (size_t)64 * K * 2;
    const size_t kstep = (size_t)(BK * 2);
    const size_t hstepA = (size_t)HALF * lda * 2, hstepB = (size_t)HALF * K * 2;
    const size_t tstepA = 2 * hstepA, tstepB = 2 * hstepB;
    const unsigned ldsw = (unsigned)wid * 1024u;
    const int aoff = lds_byte(wr * 64 + fr, fq * 8), boff = lds_byte(wc * 32 + fr, fq * 8);
#define PG8_SA(b, h) (((b) * 2 + (h)) * HTB)
#define PG8_SB(b, h) ((4 + (b) * 2 + (h)) * HTB)
#define PG8_STAGE(bufoff, gbase, voff) do { _Pragma("unroll") for (int _i = 0; _i < 2; ++_i) \
        __builtin_amdgcn_global_load_lds((const unsigned*)((const char*)(gbase) + _i * r64##voff + v_##voff), (LAS unsigned*)(lds + (bufoff) + ldsw + _i * 8192), 16, 0, 0); } while (0)
#define PG8_LDA(dst, b, h) do { _Pragma("unroll") for (int m = 0; m < 4; ++m) _Pragma("unroll") for (int k = 0; k < 2; ++k) dst[m][k] = *(const LAS bf16x8*)(lds + PG8_SA(b, h) + aoff + m * 2048 + k * 1024); } while (0)
#define PG8_LDB(dst, b, h) do { _Pragma("unroll") for (int n = 0; n < 2; ++n) _Pragma("unroll") for (int k = 0; k < 2; ++k) dst[n][k] = *(const LAS bf16x8*)(lds + PG8_SB(b, h) + boff + n * 2048 + k * 1024); } while (0)
#define PG8_MMA(ai, bj, At, Bt) do { __builtin_amdgcn_s_setprio(1); _Pragma("unroll") for (int m = 0; m < 4; ++m) _Pragma("unroll") for (int n = 0; n < 2; ++n) _Pragma("unroll") for (int k = 0; k < 2; ++k) \
        acc[ai][bj][m][n] = __builtin_amdgcn_mfma_f32_16x16x32_bf16(Bt[n][k], At[m][k], acc[ai][bj][m][n], 0, 0, 0); __builtin_amdgcn_s_setprio(0); } while (0)
#define PG8_WAIT_V(n) asm volatile("s_waitcnt vmcnt(" #n ")" ::: "memory")
#define PG8_WAIT_L(n) asm volatile("s_waitcnt lgkmcnt(" #n ")" ::: "memory")
#define PG8_BAR __builtin_amdgcn_s_barrier()
#define PG8_SCHED __builtin_amdgcn_sched_barrier(0)
    Unit cur, nxt; int ui = 0;
    if (!S.next(0, cur)) return;
    f32x4 acc[2][2][4][2];
#pragma unroll
    for (int a = 0; a < 2; ++a)
#pragma unroll
        for (int b = 0; b < 2; ++b)
#pragma unroll
            for (int m = 0; m < 4; ++m)
#pragma unroll
                for (int n = 0; n < 2; ++n) acc[a][b][m][n] = (f32x4){0.f, 0.f, 0.f, 0.f};
    bf16x8 At[4][2], B0[2][2], B1[2][2];
    const char* cA = (const char*)g.A + (size_t)cur.pm * tstepA; const char* cB = (const char*)g.Bt + (size_t)cur.pn * tstepB;
    PG8_STAGE(PG8_SB(0, 0), cB, offB); PG8_STAGE(PG8_SA(0, 0), cA, offA); PG8_STAGE(PG8_SB(0, 1), cB + hstepB, offB); PG8_STAGE(PG8_SA(0, 1), cA + hstepA, offA);
    if (wr == 1) PG8_BAR;
    PG8_WAIT_V(4); PG8_BAR;
    PG8_STAGE(PG8_SB(1, 0), cB + kstep, offB); PG8_STAGE(PG8_SA(1, 0), cA + kstep, offA); PG8_STAGE(PG8_SB(1, 1), cB + hstepB + kstep, offB);
    PG8_WAIT_V(6); PG8_BAR;
    for (;;) {
        const bool has_next = S.next(ui + 1, nxt);
        const char* nA = has_next ? (const char*)g.A + (size_t)nxt.pm * tstepA : cA; const char* nB = has_next ? (const char*)g.Bt + (size_t)nxt.pn * tstepB : cB;
        for (int t = 0; t < nt; t += 2) {
            const bool last = (t == nt - 2);
            const char* a1 = cA + (size_t)(t + 1) * kstep;
            const char* a2 = last ? nA : cA + (size_t)(t + 2) * kstep; const char* b2 = last ? nB : cB + (size_t)(t + 2) * kstep;
            const char* a3 = a2 + kstep; const char* b3 = b2 + kstep;
            PG8_LDB(B0, 0, 0); PG8_SCHED; PG8_LDA(At, 0, 0); PG8_STAGE(PG8_SA(1, 1), a1 + hstepA, offA);
            PG8_WAIT_L(8); PG8_BAR; PG8_WAIT_L(0); PG8_MMA(0, 0, At, B0); PG8_BAR; PG8_SCHED;
            PG8_LDB(B1, 0, 1); PG8_STAGE(PG8_SB(0, 0), b2, offB);
            PG8_BAR; PG8_WAIT_L(0); PG8_MMA(0, 1, At, B1); PG8_BAR;
            PG8_LDA(At, 0, 1); PG8_STAGE(PG8_SA(0, 0), a2, offA);
            PG8_BAR; PG8_WAIT_L(0); PG8_MMA(1, 0, At, B0); PG8_BAR; PG8_SCHED;
            PG8_STAGE(PG8_SB(0, 1), b2 + hstepB, offB);
            PG8_WAIT_V(6); PG8_BAR; PG8_MMA(1, 1, At, B1); PG8_BAR;
            PG8_LDB(B0, 1, 0); PG8_SCHED; PG8_LDA(At, 1, 0); PG8_STAGE(PG8_SA(0, 1), a2 + hstepA, offA);
            PG8_WAIT_L(8); PG8_BAR; PG8_WAIT_L(0); PG8_MMA(0, 0, At, B0); PG8_BAR; PG8_SCHED;
            PG8_LDB(B1, 1, 1); PG8_STAGE(PG8_SB(1, 0), b3, offB);
            PG8_BAR; PG8_WAIT_L(0); PG8_MMA(0, 1, At, B1); PG8_BAR;
            PG8_LDA(At, 1, 1); PG8_STAGE(PG8_SA(1, 0), a3, offA);
            PG8_BAR; PG8_WAIT_L(0); PG8_MMA(1, 0, At, B0); PG8_BAR; PG8_SCHED;
            PG8_STAGE(PG8_SB(1, 1), b3 + hstepB, offB);
            PG8_WAIT_V(6); PG8_BAR; PG8_MMA(1, 1, At, B1); PG8_BAR;
        }
        E(acc, cur, wr, wc, fr, fq);
        if (!has_next) break;
#pragma unroll
        for (int a = 0; a < 2; ++a)
#pragma unroll
            for (int b = 0; b < 2; ++b)
#pragma unroll
                for (int m = 0; m < 4; ++m)
#pragma unroll
                    for (int n = 0; n < 2; ++n) acc[a][b][m][n] = (f32x4){0.f, 0.f, 0.f, 0.f};
        cur = nxt; cA = nA; cB = nB; ++ui;
    }
    PG8_WAIT_V(0);
    if (wr == 0) PG8_BAR;
    PG8_BAR;
#undef PG8_SA
#undef PG8_SB
#undef PG8_STAGE
#undef PG8_LDA
#undef PG8_LDB
#undef PG8_MMA
#undef PG8_WAIT_V
#undef PG8_WAIT_L
#undef PG8_BAR
#undef PG8_SCHED
}
}

struct EpiSwiglu {
    static constexpr bool PERM = true;
    bf16_t* act;
    __device__ __forceinline__ void operator()(const f32x4 (&acc)[2][2][4][2], const pg8::Unit& u, int wr, int wc, int fr, int fq) const {
        const int row0 = u.pm * 256 + wr * 64 + fr, col0 = u.pn * 128 + wc * 32 + 8 * fq;
#pragma unroll
        for (int ai = 0; ai < 2; ++ai)
#pragma unroll
            for (int m = 0; m < 4; ++m) {
                bf16_t* rowp = act + (size_t)(row0 + ai * 128 + m * 16) * FF + col0;
                const f32x4 g0 = acc[ai][0][m][0], g1 = acc[ai][0][m][1], u0 = acc[ai][1][m][0], u1 = acc[ai][1][m][1];
                u32x4 w;
                w.x = pk2(siluf(g0[0]) * u0[0], siluf(g0[1]) * u0[1]); w.y = pk2(siluf(g0[2]) * u0[2], siluf(g0[3]) * u0[3]);
                w.z = pk2(siluf(g1[0]) * u1[0], siluf(g1[1]) * u1[1]); w.w = pk2(siluf(g1[2]) * u1[2], siluf(g1[3]) * u1[3]);
                *(u32x4*)rowp = w;
            }
    }
};
struct EpiResid {
    static constexpr bool PERM = false;
    const float* srcl; const float* srcc; float* dstl; float* dstc; const float* mod; int gi; float sc;
    __device__ __forceinline__ void operator()(const f32x4 (&acc)[2][2][4][2], const pg8::Unit& u, int wr, int wc, int fr, int fq) const {
        const int row0 = u.pm * 256 + wr * 64 + fr;
        const bool lat = u.pm < (RL / 256);
        const int bi = lat ? (u.pm >> 3) : 16;
        const float* g = mod + (size_t)(bi * 9 + gi) * 1024;
#pragma unroll
        for (int ai = 0; ai < 2; ++ai)
#pragma unroll
            for (int m = 0; m < 4; ++m) {
                const int row = row0 + ai * 128 + m * 16;
                const size_t ro = lat ? (size_t)row * 1024 : (size_t)(row - RL) * 1024;
                const float* sp = (lat ? srcl : srcc) + ro; float* dp = (lat ? dstl : dstc) + ro;
#pragma unroll
                for (int bj = 0; bj < 2; ++bj)
#pragma unroll
                    for (int n = 0; n < 2; ++n) {
                        const int col = u.pn * 256 + bj * 128 + wc * 32 + n * 16 + fq * 4;
                        const f32x4 h = *(const f32x4*)(sp + col), gg = *(const f32x4*)(g + col);
                        *(f32x4*)(dp + col) = h + (gg * sc) * acc[ai][bj][m][n];
                    }
            }
    }
};
template <int LDC, bool GATES>
struct EpiStore {
    static constexpr bool PERM = true;
    bf16_t* O; float* gates;
    __device__ __forceinline__ void operator()(const f32x4 (&acc)[2][2][4][2], const pg8::Unit& u, int wr, int wc, int fr, int fq) const {
        const int row0 = u.pm * 256 + wr * 64 + fr, col0 = u.pn * 256 + wc * 32 + 8 * fq;
        bf16_t* base = O + (size_t)row0 * LDC + col0;
#pragma unroll
        for (int ai = 0; ai < 2; ++ai)
#pragma unroll
            for (int m = 0; m < 4; ++m) {
#pragma unroll
                for (int bj = 0; bj < 2; ++bj) {
                    const f32x4 v0 = acc[ai][bj][m][0], v1 = acc[ai][bj][m][1];
                    u32x4 w; w.x = pk2(v0[0], v0[1]); w.y = pk2(v0[2], v0[3]); w.z = pk2(v1[0], v1[1]); w.w = pk2(v1[2], v1[3]);
                    *(u32x4*)(base + (ai * 128 + m * 16) * LDC + bj * 128) = w;
                }
            }
        if (GATES) {
            if (u.pn == 10 && wc == 1 && fq < 3) {
                float* gp = gates + (size_t)row0 * 32 + 8 * fq;
#pragma unroll
                for (int ai = 0; ai < 2; ++ai)
#pragma unroll
                    for (int m = 0; m < 4; ++m) { *(f32x4*)(gp + (ai * 128 + m * 16) * 32) = acc[ai][1][m][0]; *(f32x4*)(gp + (ai * 128 + m * 16) * 32 + 4) = acc[ai][1][m][1]; }
            }
        }
    }
};
static_assert(UC_MG == 2560 + 128 + 32, "gate columns sit at tile 10, bj 1, wc 1");

constexpr int PARAM_OFF = LDS_BYTES - 512;
struct Ctx {
    unsigned char* lds; LAS unsigned char* ldsl; int tid, lane, wave;
    float* hc; float* mod; float* gates; unsigned char* wb; bf16_t* xn; bf16_t* U;
    __device__ __forceinline__ unsigned long long ptr(int i) const {
        const LAS unsigned* q = (const LAS unsigned*)(ldsl + PARAM_OFF) + 2 * i;
        const unsigned lo = __builtin_amdgcn_readfirstlane(q[0]), hi = __builtin_amdgcn_readfirstlane(q[1]);
        return ((unsigned long long)hi << 32) | lo; }
    __device__ __forceinline__ const float* in(int i) const { return (const float*)ptr(i); }
    __device__ __forceinline__ float* out() const { return (float*)ptr(32); }
    __device__ __forceinline__ unsigned char* ws() const { return (unsigned char*)ptr(33); }
};

__device__ __forceinline__ void mod_phase(const Ctx& c) {
    float* sc = (float*)c.lds;
    float* red = sc + 17 * 1024;
    const float* cv = c.in(I_C); const float* cc = c.in(I_CCTX);
    for (int i = c.tid; i < 17 * 1024; i += NTHR) { const int bi = i >> 10, k = i & 1023; const float v = bi < 16 ? cv[bi * 1024 + k] : cc[k]; sc[i] = siluf(v); }
    __syncthreads();
    for (int task = blockIdx.x; task < 288; task += gridDim.x) {
        const int l = task / 144, cgp = task % 144;
        const float* w = c.in(I_WMOD) + (size_t)l * 1024 * 9216 + cgp * 64 + c.lane;
        float acc[17];
#pragma unroll
        for (int b = 0; b < 17; ++b) acc[b] = 0.f;
#pragma unroll 4
        for (int kk = 0; kk < 128; ++kk) {
            const int k = c.wave * 128 + kk; const float wv = w[(size_t)k * 9216];
#pragma unroll
            for (int b = 0; b < 17; ++b) acc[b] += sc[b * 1024 + k] * wv;
        }
#pragma unroll
        for (int b = 0; b < 17; ++b) red[(c.wave * 17 + b) * 64 + c.lane] = acc[b];
        __syncthreads();
        for (int o = c.tid; o < 17 * 64; o += NTHR) {
            const int b = o >> 6, ln = o & 63; float s = 0.f;
#pragma unroll
            for (int wv = 0; wv < 8; ++wv) s += red[(wv * 17 + b) * 64 + ln];
            s += c.in(I_BMOD)[l * 9216 + cgp * 64 + ln];
            c.mod[(size_t)(l * 17 + b) * 9216 + cgp * 64 + ln] = s;
        }
        __syncthreads();
    }
}

template <class F>
__device__ __forceinline__ void conv_job(const Ctx& c, bf16_t* Bt, int K, int Ndst, F src) {
    float* tile = (float*)c.lds;
    const int nk = K / 64, nn = Ndst / 64;
    for (int t = blockIdx.x; t < nk * nn; t += gridDim.x) {
        const int n0 = (t / nk) * 64, k0 = (t % nk) * 64;
#pragma unroll
        for (int e = 0; e < 8; ++e) { const int idx = c.tid + e * NTHR, n_ = idx & 63, kk = idx >> 6; tile[kk * 65 + n_] = src(n0 + n_, k0 + kk); }
        __syncthreads();
#pragma unroll
        for (int e = 0; e < 4; ++e) { const int idx = c.tid + e * NTHR, kp = idx & 31, n_ = idx >> 5;
            *(unsigned*)(Bt + (size_t)(n0 + n_) * K + k0 + 2 * kp) = pk2(tile[(2 * kp) * 65 + n_], tile[(2 * kp + 1) * 65 + n_]); }
        __syncthreads();
    }
}
__device__ __forceinline__ int win_map(int n) {
    if (n < 256) return n;
    if (n < 512) return 1456 + (n - 256);
    if (n < 768) return 1968 + (n - 512);
    if (n < 1024) return 1040 + (n - 768);
    if (n < 1152) return 1296 + (n - 1024);
    if (n < 1184) return 1424 + (n - 1152);
    if (n < 1440) return 256 + (n - 1184);
    if (n < 1696) return 512 + (n - 1440);
    if (n < 1952) return 768 + (n - 1696);
    if (n < 2080) return 1712 + (n - 1952);
    if (n < 2208) return 1840 + (n - 2080);
    if (n < 2720) return 2224 + (n - 2208);
    if (n < 2736) return 1024 + (n - 2720);
    if (n < 2744) return 2736 + (n - 2736);
    return -1;
}
__device__ __forceinline__ void conv_phase(const Ctx& c, int l) {
    unsigned char* wb = c.wb;
    { const float* W = c.in(I_F1WI) + (size_t)l * 1024 * 5632;
      conv_job(c, (bf16_t*)(wb + WB_WI1), 1024, 5632, [=](int n, int k) { const int t = n >> 8, w = n & 255; const int col = w < 128 ? t * 128 + w : FF + t * 128 + (w - 128); return W[(size_t)k * 5632 + col]; }); }
    { const float* W = c.in(I_F2WI) + (size_t)l * 1024 * 5632;
      conv_job(c, (bf16_t*)(wb + WB_WI2), 1024, 5632, [=](int n, int k) { const int t = n >> 8, w = n & 255; const int col = w < 128 ? t * 128 + w : FF + t * 128 + (w - 128); return W[(size_t)k * 5632 + col]; }); }
    { const float* W = c.in(I_F1WO) + (size_t)l * 2816 * 1024;
      conv_job(c, (bf16_t*)(wb + WB_WO1), 2816, 1024, [=](int n, int k) { return W[(size_t)k * 1024 + n]; }); }
    { const float* W = c.in(I_F2WO) + (size_t)l * 2816 * 1024;
      conv_job(c, (bf16_t*)(wb + WB_WO2), 2816, 1024, [=](int n, int k) { return W[(size_t)k * 1024 + n]; }); }
    { const float* W = c.in(I_WIN) + (size_t)l * 1024 * 2744;
      conv_job(c, (bf16_t*)(wb + WB_WIN), 1024, 2816, [=](int n, int k) { const int col = win_map(n); return col >= 0 ? W[(size_t)k * 2744 + col] : 0.f; }); }
    { const float* W = c.in(I_WOUT) + (size_t)l * 1024 * 1024;
      conv_job(c, (bf16_t*)(wb + WB_WOUT), 1024, 1024, [=](int n, int k) { const int ko = k < 256 ? k : (k < 512 ? k + 256 : (k < 768 ? k + 256 : k - 512)); return W[(size_t)ko * 1024 + n]; }); }
    { const float* Wq = c.in(I_AWQ) + (size_t)l * 256 * 384; const float* Wkv = c.in(I_AWKV) + (size_t)l * 128 * 512;
      const float* qn = c.in(I_AQN) + l * 256; const float* kvn = c.in(I_AKVN) + l * 128;
      conv_job(c, (bf16_t*)(wb + WB_MLA), 384, 1024, [=](int n, int k) {
          if (n < 384) return k < 256 ? qn[k] * Wq[(size_t)k * 384 + n] : 0.f;
          if (n < 896) return k >= 256 ? kvn[k - 256] * Wkv[(size_t)(k - 256) * 512 + (n - 384)] : 0.f;
          return 0.f; }); }
}

__device__ __forceinline__ void norm_phase(const Ctx& c, const float* srcl, const float* srcc, int nrows, const float* gain, const float* mod, int ish, int isc) {
    for (int row = blockIdx.x * 8 + c.wave; row < nrows; row += gridDim.x * 8) {
        const bool lat = row < RL;
        const float* h = lat ? srcl + (size_t)row * 1024 : srcc + (size_t)(row - RL) * 1024;
        const int bi = lat ? (row >> 11) : 16;
        f32x4 v[4]; float ss = 0.f;
#pragma unroll
        for (int i = 0; i < 4; ++i) { v[i] = *(const f32x4*)(h + i * 256 + c.lane * 4); ss += v[i][0] * v[i][0] + v[i][1] * v[i][1] + v[i][2] * v[i][2] + v[i][3] * v[i][3]; }
        ss = wave_sum(ss);
        const float rstd = rsqrtf(ss * (1.f / 1024.f) + EPS);
        const float* shp = mod + (size_t)(bi * 9 + ish) * 1024; const float* scp = mod + (size_t)(bi * 9 + isc) * 1024;
#pragma unroll
        for (int i = 0; i < 4; ++i) {
            const int col = i * 256 + c.lane * 4;
            const f32x4 g = *(const f32x4*)(gain + col), s4 = *(const f32x4*)(scp + col), h4 = *(const f32x4*)(shp + col);
            const f32x4 y = (v[i] * rstd * g) * (s4 + 1.f) + h4;
            u32x2 w; w.x = pk2(y[0], y[1]); w.y = pk2(y[2], y[3]);
            *(u32x2*)(c.xn + (size_t)row * 1024 + col) = w;
        }
    }
}

#if N_MIX

__device__ __forceinline__ int chunk_row(int b, int tc) { return tc < 4 ? RL + b * CL + tc * 64 : b * TL + (tc - 4) * 64; }
__device__ __forceinline__ int scan_idx(int d, int tc) { return d == 0 ? tc : (tc < 4 ? 3 - tc : 39 - tc); }
__device__ __forceinline__ float wave_incl_scan(float v, int lane) {
#pragma unroll
    for (int o = 1; o < 64; o <<= 1) { const float t = __shfl_up(v, o); if (lane >= o) v += t; }
    return v;
}
__device__ __forceinline__ void ld8(const bf16_t* p, float (&o)[8]) {
    const u32x4 w = *(const u32x4*)p;
    o[0] = __uint_as_float(w.x << 16); o[1] = __uint_as_float(w.x & 0xffff0000u); o[2] = __uint_as_float(w.y << 16); o[3] = __uint_as_float(w.y & 0xffff0000u);
    o[4] = __uint_as_float(w.z << 16); o[5] = __uint_as_float(w.z & 0xffff0000u); o[6] = __uint_as_float(w.w << 16); o[7] = __uint_as_float(w.w & 0xffff0000u);
}
__device__ __forceinline__ void st8(bf16_t* p, const float (&v)[8]) {
    u32x4 w; w.x = pk2(v[0], v[1]); w.y = pk2(v[2], v[3]); w.z = pk2(v[4], v[5]); w.w = pk2(v[6], v[7]); *(u32x4*)p = w;
}

__device__ __forceinline__ void swa_prep(const Ctx& c, int l, int b, int tc) {
    bf16_t* vs = (bf16_t*)c.lds;
    const int rowbase = chunk_row(b, tc); const bool lat = tc >= 4;
    bf16_t* Ksw = (bf16_t*)(c.ws() + WS_KS); bf16_t* Vts = (bf16_t*)(c.ws() + WS_VTS);
    const float qg = c.in(I_SQG)[l * 64 + c.lane], kg = c.in(I_SKG)[l * 64 + c.lane];
    const int a = c.lane >> 5, pp = (c.lane >> 4) & 1, f = c.lane & 15;
    const float inv = __expf(-(float)f * (1.f / 16.f) * 9.210340372f);
    __syncthreads();
#pragma unroll 1
    for (int r = 0; r < 8; ++r) {
        const int j = c.wave * 8 + r, row = rowbase + j;
        bf16_t* up = c.U + (size_t)row * UC;
        float cs = 1.f, sn = 0.f;
        if (lat) { const float ang = (float)(a ? j : (tc - 4)) * inv; sincosf(ang, &sn, &cs); }
#pragma unroll
        for (int h = 0; h < 4; ++h) {
            const float x = bf2f(up[UC_WQ + h * 64 + c.lane]);
            const float ms = wave_sum(x * x) * (1.f / 64.f);
            float y = x * rsqrtf(ms + EPS) * qg;
            const float pr = __shfl_xor(y, 16);
            y = pp == 0 ? y * cs - pr * sn : y * cs + pr * sn;
            up[UC_WQ + h * 64 + c.lane] = f2bf(y);
        }
#pragma unroll
        for (int kv = 0; kv < 2; ++kv) {
            const float x = bf2f(up[UC_WK + kv * 64 + c.lane]);
            const float ms = wave_sum(x * x) * (1.f / 64.f);
            float y = x * rsqrtf(ms + EPS) * kg;
            const float pr = __shfl_xor(y, 16);
            y = pp == 0 ? y * cs - pr * sn : y * cs + pr * sn;
            Ksw[((size_t)(b * 2 + kv) * KEYS + tc * 64 + j) * 64 + c.lane] = f2bf(y);
            vs[j * 128 + kv * 64 + c.lane] = up[UC_WV + kv * 64 + c.lane];
        }
    }
    __syncthreads();
    { const int kd = c.tid >> 2, jq = c.tid & 3;
      bf16_t* dst = Vts + ((size_t)(b * 2 + (kd >> 6)) * 64 + (kd & 63)) * KEYS + tc * 64 + jq * 16;
      unsigned w[8];
#pragma unroll
      for (int i = 0; i < 8; ++i) w[i] = (unsigned)vs[(jq * 16 + 2 * i) * 128 + kd] | ((unsigned)vs[(jq * 16 + 2 * i + 1) * 128 + kd] << 16);
      *(u32x4*)dst = (u32x4){w[0], w[1], w[2], w[3]}; *(u32x4*)(dst + 8) = (u32x4){w[4], w[5], w[6], w[7]}; }
}

__device__ __forceinline__ void mlstm_local(const Ctx& c, int l, int b, int hh, int tc) {
    float* kf = (float*)c.lds; float* vf = kf + 4096; float* wf = vf + 4096; float* wb = wf + 64;
    const int rowbase = chunk_row(b, tc);
    bf16_t* STM = (bf16_t*)(c.ws() + WS_STM); float* DECM = (float*)(c.ws() + WS_DECM);
    __syncthreads();
    { const int j = c.tid >> 3, cg8 = c.tid & 7; const bf16_t* up = c.U + (size_t)(rowbase + j) * UC + hh * 64 + cg8 * 8;
      float k8[8], v8[8]; ld8(up + UC_MK, k8); ld8(up + UC_MV, v8);
#pragma unroll
      for (int i = 0; i < 8; ++i) { kf[j * 64 + cg8 * 8 + i] = k8[i] * 0.125f; vf[j * 64 + cg8 * 8 + i] = v8[i]; } }
    if (c.wave == 0) {
        const float* gp = c.gates + (size_t)(rowbase + c.lane) * 32; const float* gb = c.in(I_MGB) + l * 16;
        const float i_f = gp[hh] + gb[hh], f_f = logsigf(gp[4 + hh] + gb[4 + hh]), i_b = gp[8 + hh] + gb[8 + hh], f_b = logsigf(gp[12 + hh] + gb[12 + hh]);
        const float cf = wave_incl_scan(f_f, c.lane), cb = wave_incl_scan(f_b, c.lane);
        const float totf = __shfl(cf, 63), totb = __shfl(cb, 63);
        wf[c.lane] = __expf(i_f + totf - cf);
        wb[c.lane] = __expf(i_b + cb - f_b);
        if (c.lane == 0) { DECM[((b * 4 + hh) * 2 + 0) * NCH + scan_idx(0, tc)] = __expf(totf); DECM[((b * 4 + hh) * 2 + 1) * NCH + scan_idx(1, tc)] = __expf(totb); }
    }
    __syncthreads();
    const int dk = c.tid >> 3, dvg = c.tid & 7;
    float af[8], ab[8], nf = 0.f, nb = 0.f;
#pragma unroll
    for (int i = 0; i < 8; ++i) { af[i] = 0.f; ab[i] = 0.f; }
#pragma unroll 2
    for (int j = 0; j < 64; ++j) {
        const float kk = kf[j * 64 + dk], a = kk * wf[j], bb = kk * wb[j];
        const f32x4 v0 = *(const f32x4*)(vf + j * 64 + dvg * 8), v1 = *(const f32x4*)(vf + j * 64 + dvg * 8 + 4);
#pragma unroll
        for (int i = 0; i < 4; ++i) { af[i] += a * v0[i]; af[4 + i] += a * v1[i]; ab[i] += bb * v0[i]; ab[4 + i] += bb * v1[i]; }
        nf += a; nb += bb;
    }
    bf16_t* s0 = STM + ((size_t)((b * 4 + hh) * 2 + 0) * NCH + scan_idx(0, tc)) * 4160;
    bf16_t* s1 = STM + ((size_t)((b * 4 + hh) * 2 + 1) * NCH + scan_idx(1, tc)) * 4160;
    st8(s0 + dk * 64 + dvg * 8, af); st8(s1 + dk * 64 + dvg * 8, ab);
    if (dvg == 0) { s0[4096 + dk] = f2bf(nf); s1[4096 + dk] = f2bf(nb); }
}

__device__ __forceinline__ int ssd_gch(int grp, int lc) { return lc < 128 ? grp * 128 + lc : (lc < 192 ? 256 + grp * 64 + (lc - 128) : 384 + grp * 64 + (lc - 192)); }
template <bool WANT_C>
__device__ __forceinline__ void ssd_conv(const Ctx& c, int l, int b, int grp, int tc, bf16_t* xin, float* xc, float* Bd, int bstride_n, int bstride_s, float* Cc) {
    const int rowbase = chunk_row(b, tc); const int lcn = tc < 4 ? tc : tc - 4, nchk = tc < 4 ? 4 : 32;
    for (int idx = c.tid; idx < 68 * 32; idx += NTHR) {
        const int rr = idx >> 5, ch8 = idx & 31, lc = ch8 * 8;
        const int trel = rr - 2; const bool ok = !((lcn == 0 && trel < 0) || (lcn == nchk - 1 && trel >= 64));
        u32x4 w = (u32x4){0u, 0u, 0u, 0u};
        if (ok) w = *(const u32x4*)(c.U + (size_t)(rowbase + trel) * UC + UC_XBC + ssd_gch(grp, lc));
        *(u32x4*)(xin + rr * 256 + lc) = w;
    }
    __syncthreads();
    { const int lc = c.tid & 255, jh = c.tid >> 8, gch = ssd_gch(grp, lc);
      const float* cw = c.in(I_CW) + (size_t)l * 5 * 512 + gch; const float w0 = cw[0], w1 = cw[512], w2 = cw[1024], w3 = cw[1536], w4 = cw[2048], bias = c.in(I_CB)[l * 512 + gch];
      if (WANT_C || lc < 192) {
#pragma unroll 2
        for (int j = jh * 32; j < jh * 32 + 32; ++j) {
            const float y = bias + w0 * bf2f(xin[j * 256 + lc]) + w1 * bf2f(xin[(j + 1) * 256 + lc]) + w2 * bf2f(xin[(j + 2) * 256 + lc]) + w3 * bf2f(xin[(j + 3) * 256 + lc]) + w4 * bf2f(xin[(j + 4) * 256 + lc]);
            const float v = siluf(y);
            if (lc < 128) xc[j * 128 + lc] = v; else if (lc < 192) Bd[(lc - 128) * bstride_n + j * bstride_s] = v; else if (WANT_C) Cc[j * 65 + (lc - 192)] = v;
        }
      } }
}
__device__ __forceinline__ void ssd_gate(const Ctx& c, int l, int row, int h, int d, float& a, float& dt, float& pf, float& tot) {
    dt = softplusf(c.gates[(size_t)row * 32 + 16 + d * 4 + h] + c.in(I_DTB)[l * 8 + d * 4 + h]);
    a = -__expf(c.in(I_ALOG)[l * 8 + d * 4 + h]) * dt;
    pf = wave_incl_scan(a, c.lane); tot = __shfl(pf, 63);
}
__device__ __forceinline__ void ssd_local(const Ctx& c, int l, int b, int grp, int tc) {
    bf16_t* xin = (bf16_t*)c.lds; float* xc = (float*)(c.lds + 68 * 256 * 2); float* Bc = xc + 64 * 128; float* wd = Bc + 64 * 64;
    bf16_t* STS = (bf16_t*)(c.ws() + WS_STS); float* DECS = (float*)(c.ws() + WS_DECS);
    const int rowbase = chunk_row(b, tc);
    __syncthreads();
    ssd_conv<false>(c, l, b, grp, tc, xin, xc, Bc, 1, 64, nullptr);
    if (c.wave < 4) {
        const int hl = c.wave >> 1, d = c.wave & 1, h = grp * 2 + hl; float a, dt, pf, tot;
        ssd_gate(c, l, rowbase + c.lane, h, d, a, dt, pf, tot);
        wd[c.wave * 64 + c.lane] = (d == 0 ? __expf(tot - pf) : __expf(pf - a)) * dt;
        if (c.lane == 0) DECS[((b * 4 + h) * 2 + d) * NCH + scan_idx(d, tc)] = __expf(tot);
    }
    __syncthreads();
    const int n = c.tid >> 3, pg = c.tid & 7;
    float acc[4][8];
#pragma unroll
    for (int q = 0; q < 4; ++q)
#pragma unroll
        for (int i = 0; i < 8; ++i) acc[q][i] = 0.f;
#pragma unroll 2
    for (int j = 0; j < 64; ++j) {
        const float bv = Bc[j * 64 + n];
#pragma unroll
        for (int hl = 0; hl < 2; ++hl) {
            const f32x4 x0 = *(const f32x4*)(xc + j * 128 + hl * 64 + pg * 8), x1 = *(const f32x4*)(xc + j * 128 + hl * 64 + pg * 8 + 4);
#pragma unroll
            for (int d = 0; d < 2; ++d) { const float w = wd[(hl * 2 + d) * 64 + j] * bv;
#pragma unroll
                for (int i = 0; i < 4; ++i) { acc[hl * 2 + d][i] += w * x0[i]; acc[hl * 2 + d][4 + i] += w * x1[i]; } }
        }
    }
#pragma unroll
    for (int hl = 0; hl < 2; ++hl)
#pragma unroll
        for (int d = 0; d < 2; ++d)
            st8(STS + ((size_t)((b * 4 + grp * 2 + hl) * 2 + d) * NCH + scan_idx(d, tc)) * 4096 + n * 64 + pg * 8, acc[hl * 2 + d]);
}

__device__ __forceinline__ void scan_task(const Ctx& c, bf16_t* ST, const float* DEC, int chain, int pairs, int blk) {
    const int pi = blk * NTHR + c.tid; if (pi >= pairs) return;
    unsigned* p = (unsigned*)(ST + (size_t)chain * NCH * (pairs * 2)) + pi; const float* dec = DEC + chain * NCH;
    float c0 = 0.f, c1 = 0.f;
#pragma unroll 4
    for (int k = 0; k < NCH; ++k) {
        const unsigned u = p[(size_t)k * pairs]; const float dk = dec[k];
        p[(size_t)k * pairs] = pk2(c0, c1);
        c0 = dk * c0 + __uint_as_float(u << 16); c1 = dk * c1 + __uint_as_float(u & 0xffff0000u);
    }
}

__device__ __forceinline__ void mla_finish(const Ctx& c, int l, int b, int tc) {
    bf16_t* vs = (bf16_t*)c.lds;
    const int rowbase = chunk_row(b, tc); const bool lat = tc >= 4;
    bf16_t* QM = (bf16_t*)(c.ws() + WS_QM); bf16_t* KM = (bf16_t*)(c.ws() + WS_KM); bf16_t* VTM = (bf16_t*)(c.ws() + WS_VTM);
    const bf16_t* QKV = c.xn;
    const float qgn = c.in(I_AQG)[l * 96 + c.lane], kgn = c.in(I_AKG)[l * 96 + c.lane];
    const float qgr = c.lane < 32 ? c.in(I_AQG)[l * 96 + 64 + c.lane] : 0.f, kgr = c.lane < 32 ? c.in(I_AKG)[l * 96 + 64 + c.lane] : 0.f;
    const int a = (c.lane >> 4) & 1, pp = (c.lane >> 3) & 1, f = c.lane & 7;
    const float inv = __expf(-(float)f * (1.f / 8.f) * 9.210340372f);
    __syncthreads();
#pragma unroll 1
    for (int r = 0; r < 8; ++r) {
        const int j = c.wave * 8 + r, row = rowbase + j, pos = tc * 64 + j;
        const bf16_t* up = c.U + (size_t)row * UC; const bf16_t* rp = QKV + (size_t)row * 1024;
        float cs = 1.f, sn = 0.f;
        if (lat) { const float ang = (float)(a ? j : (tc - 4)) * inv; sincosf(ang, &sn, &cs); }
        float ss;
        { const u32x2 w = *(const u32x2*)(up + UC_AQ + c.lane * 4); const float x0 = __uint_as_float(w.x << 16), x1 = __uint_as_float(w.x & 0xffff0000u), x2 = __uint_as_float(w.y << 16), x3 = __uint_as_float(w.y & 0xffff0000u);
          ss = wave_sum(x0 * x0 + x1 * x1 + x2 * x2 + x3 * x3); }
        const float rq = rsqrtf(ss * (1.f / 256.f) + EPS);
        { const unsigned w = *(const unsigned*)(up + UC_AKV + c.lane * 2); const float x0 = __uint_as_float(w << 16), x1 = __uint_as_float(w & 0xffff0000u); ss = wave_sum(x0 * x0 + x1 * x1); }
        const float rkv = rsqrtf(ss * (1.f / 128.f) + EPS);
#pragma unroll
        for (int h = 0; h < 4; ++h) {
            const size_t qo = ((size_t)(b * 4 + h) * KEYS + pos) * 96;
            { const float x = bf2f(rp[h * 96 + c.lane]) * rq; const float ms = wave_sum(x * x) * (1.f / 64.f); QM[qo + c.lane] = f2bf(x * rsqrtf(ms + EPS) * qgn); }
            { const float x = c.lane < 32 ? bf2f(rp[h * 96 + 64 + c.lane]) * rq : 0.f; const float ms = wave_sum(x * x) * (1.f / 32.f);
              float y = x * rsqrtf(ms + EPS) * qgr; const float pr = __shfl_xor(y, 8); y = pp == 0 ? y * cs - pr * sn : y * cs + pr * sn;
              if (c.lane < 32) QM[qo + 64 + c.lane] = f2bf(y); }
            { const float x = bf2f(rp[384 + h * 128 + c.lane]) * rkv; const float ms = wave_sum(x * x) * (1.f / 64.f); KM[qo + c.lane] = f2bf(x * rsqrtf(ms + EPS) * kgn); }
            vs[j * 256 + h * 64 + c.lane] = f2bf(bf2f(rp[384 + h * 128 + 64 + c.lane]) * rkv);
        }
        { const float x = c.lane < 32 ? bf2f(up[UC_AKR + c.lane]) : 0.f; const float ms = wave_sum(x * x) * (1.f / 32.f);
          float y = x * rsqrtf(ms + EPS) * kgr; const float pr = __shfl_xor(y, 8); y = pp == 0 ? y * cs - pr * sn : y * cs + pr * sn;
          if (c.lane < 32) {
#pragma unroll
              for (int h = 0; h < 4; ++h) KM[((size_t)(b * 4 + h) * KEYS + pos) * 96 + 64 + c.lane] = f2bf(y); } }
    }
    __syncthreads();
    { const int hd = c.tid >> 1, jh = c.tid & 1;
      bf16_t* dst = VTM + ((size_t)(b * 4 + (hd >> 6)) * 64 + (hd & 63)) * KEYS + tc * 64 + jh * 32;
#pragma unroll
      for (int q = 0; q < 4; ++q) { unsigned w[4];
#pragma unroll
          for (int i = 0; i < 4; ++i) w[i] = (unsigned)vs[(jh * 32 + q * 8 + 2 * i) * 256 + hd] | ((unsigned)vs[(jh * 32 + q * 8 + 2 * i + 1) * 256 + hd] << 16);
          *(u32x4*)(dst + q * 8) = (u32x4){w[0], w[1], w[2], w[3]}; } }
}

template <int DQ>
__device__ __forceinline__ void attn_task(const Ctx& c, const bf16_t* Qp, int qstride, const bf16_t* Kb, const bf16_t* Vtb, int nloc, int loc0, bool masked, int tq0,
                                          float scale, float sink, bool has_sink, bf16_t* Op, int ostride) {
    constexpr int KS = DQ + 8;
    bf16_t* Ks = (bf16_t*)c.lds; bf16_t* Vs = Ks + 64 * KS; bf16_t* Ps = Vs + 64 * 72;
    const int fr = c.lane & 15, fq = c.lane >> 4;
    bf16x8 qa[DQ / 32];
    { const bf16_t* qrow = Qp + (size_t)(c.wave * 16 + fr) * qstride;
#pragma unroll
      for (int kc = 0; kc < DQ / 32; ++kc) qa[kc] = *(const bf16x8*)(qrow + kc * 32 + fq * 8); }
    f32x4 o[4]; float m[4], ls[4];
#pragma unroll
    for (int i = 0; i < 4; ++i) { o[i] = (f32x4){0.f, 0.f, 0.f, 0.f}; m[i] = has_sink ? sink : -1e30f; ls[i] = (has_sink && fr == 0) ? 1.f : 0.f; }
    bf16_t* Pw = Ps + c.wave * 16 * 72;
    const int ntiles = 4 + nloc;
#pragma unroll 1
    for (int it = 0; it < ntiles; ++it) {
        const int tile = it < 4 ? it : loc0 + (it - 4);
        __syncthreads();
        for (int idx = c.tid; idx < 64 * (DQ / 8); idx += NTHR) { const int r = idx / (DQ / 8), ch = idx % (DQ / 8);
            *(u32x4*)(Ks + r * KS + ch * 8) = *(const u32x4*)(Kb + (size_t)(tile * 64 + r) * DQ + ch * 8); }
        { const int r = c.tid >> 3, ch = c.tid & 7; *(u32x4*)(Vs + r * 72 + ch * 8) = *(const u32x4*)(Vtb + (size_t)r * KEYS + tile * 64 + ch * 8); }
        __syncthreads();
        f32x4 s[4];
#pragma unroll
        for (int nt = 0; nt < 4; ++nt) { s[nt] = (f32x4){0.f, 0.f, 0.f, 0.f};
#pragma unroll
            for (int kc = 0; kc < DQ / 32; ++kc) { const bf16x8 kb = *(const bf16x8*)(Ks + (nt * 16 + fr) * KS + kc * 32 + fq * 8); s[nt] = __builtin_amdgcn_mfma_f32_16x16x32_bf16(qa[kc], kb, s[nt], 0, 0, 0); } }
        const bool mk = masked && it >= 4;
#pragma unroll
        for (int j = 0; j < 4; ++j) {
            float mx = -1e30f;
#pragma unroll
            for (int nt = 0; nt < 4; ++nt) { float v = s[nt][j] * scale;
                if (mk) { const int dd = (tq0 + c.wave * 16 + fq * 4 + j) - ((tile - 4) * 64 + nt * 16 + fr); if (dd > 128 || dd < -128) v = -1e30f; }
                s[nt][j] = v; mx = fmaxf(mx, v); }
            mx = fmaxf(mx, __shfl_xor(mx, 1)); mx = fmaxf(mx, __shfl_xor(mx, 2)); mx = fmaxf(mx, __shfl_xor(mx, 4)); mx = fmaxf(mx, __shfl_xor(mx, 8));
            const float mn = fmaxf(m[j], mx), al = __expf(m[j] - mn); m[j] = mn; ls[j] *= al;
#pragma unroll
            for (int dv = 0; dv < 4; ++dv) o[dv][j] *= al;
#pragma unroll
            for (int nt = 0; nt < 4; ++nt) { const float pv = __expf(s[nt][j] - mn); ls[j] += pv; Pw[(fq * 4 + j) * 72 + nt * 16 + fr] = f2bf(pv); }
        }
        __syncthreads();
#pragma unroll
        for (int kc = 0; kc < 2; ++kc) { const bf16x8 pa = *(const bf16x8*)(Pw + fr * 72 + kc * 32 + fq * 8);
#pragma unroll
            for (int dv = 0; dv < 4; ++dv) { const bf16x8 vb = *(const bf16x8*)(Vs + (dv * 16 + fr) * 72 + kc * 32 + fq * 8); o[dv] = __builtin_amdgcn_mfma_f32_16x16x32_bf16(pa, vb, o[dv], 0, 0, 0); } }
    }
#pragma unroll
    for (int j = 0; j < 4; ++j) {
        float lt = ls[j]; lt += __shfl_xor(lt, 1); lt += __shfl_xor(lt, 2); lt += __shfl_xor(lt, 4); lt += __shfl_xor(lt, 8);
        const float il = 1.f / lt;
#pragma unroll
        for (int dv = 0; dv < 4; ++dv) Op[(size_t)(c.wave * 16 + fq * 4 + j) * ostride + dv * 16 + fr] = f2bf(o[dv][j] * il);
    }
}

__device__ __forceinline__ void mlstm_out(const Ctx& c, int l, int b, int hh, int tc) {
    float* qf = (float*)c.lds; float* kT = qf + 64 * 65; float* vf = kT + 64 * 68; float* Cs = vf + 4096; float* nv = Cs + 4096; float* Sm = nv + 64; float* bcum = Sm + 64 * 65; float* ig = bcum + 64;
    const int rowbase = chunk_row(b, tc);
    const bf16_t* STM = (const bf16_t*)(c.ws() + WS_STM);
    const int t = c.tid >> 3, eg = c.tid & 7;
    __syncthreads();
    { const bf16_t* up = c.U + (size_t)(rowbase + t) * UC + hh * 64 + eg * 8; float q8[8], k8[8], v8[8]; ld8(up + UC_MQ, q8); ld8(up + UC_MK, k8); ld8(up + UC_MV, v8);
#pragma unroll
      for (int i = 0; i < 8; ++i) { qf[t * 65 + eg * 8 + i] = q8[i]; kT[(eg * 8 + i) * 68 + t] = k8[i] * 0.125f; vf[t * 64 + eg * 8 + i] = v8[i]; } }
    float hacc[8];
#pragma unroll
    for (int i = 0; i < 8; ++i) hacc[i] = 0.f;
#pragma unroll 1
    for (int d = 0; d < 2; ++d) {
        __syncthreads();
        if (c.wave == 0) {
            const float* gp = c.gates + (size_t)(rowbase + c.lane) * 32; const float* gb = c.in(I_MGB) + l * 16;
            const float iv = gp[d * 8 + hh] + gb[d * 8 + hh], fv = logsigf(gp[d * 8 + 4 + hh] + gb[d * 8 + 4 + hh]);
            const float pf = wave_incl_scan(fv, c.lane), tot = __shfl(pf, 63);
            bcum[c.lane] = d == 0 ? pf : (tot - pf + fv); ig[c.lane] = iv;
        }
        { const bf16_t* st = STM + ((size_t)((b * 4 + hh) * 2 + d) * NCH + scan_idx(d, tc)) * 4160; float s8[8]; ld8(st + c.tid * 8, s8);
#pragma unroll
          for (int i = 0; i < 8; ++i) Cs[c.tid * 8 + i] = s8[i];
          if (c.tid < 64) nv[c.tid] = bf2f(st[4096 + c.tid]); }
        __syncthreads();
        const float bt = bcum[t], ebt = __expf(bt);
        float den;
        { float a8[8];
#pragma unroll
          for (int i = 0; i < 8; ++i) a8[i] = 0.f;
#pragma unroll 2
          for (int dk = 0; dk < 64; ++dk) { const float qv = qf[t * 65 + dk]; const f32x4 k0 = *(const f32x4*)(kT + dk * 68 + eg * 8), k1 = *(const f32x4*)(kT + dk * 68 + eg * 8 + 4);
#pragma unroll
              for (int i = 0; i < 4; ++i) { a8[i] += qv * k0[i]; a8[4 + i] += qv * k1[i]; } }
          float part = 0.f;
#pragma unroll
          for (int i = 0; i < 8; ++i) { const int s = eg * 8 + i; const bool ok = d == 0 ? (s <= t) : (s >= t);
              const float v = ok ? a8[i] * __expf(bt - bcum[s] + ig[s]) : 0.f; Sm[t * 65 + s] = v; part += v; }
          float qn = 0.f;
#pragma unroll
          for (int i = 0; i < 8; ++i) qn += qf[t * 65 + eg * 8 + i] * nv[eg * 8 + i];
          part += ebt * qn;
          part += __shfl_xor(part, 1); part += __shfl_xor(part, 2); part += __shfl_xor(part, 4);
          den = part; }
        __syncthreads();
        { float n8[8];
#pragma unroll
          for (int i = 0; i < 8; ++i) n8[i] = 0.f;
#pragma unroll 2
          for (int dk = 0; dk < 64; ++dk) { const float qv = qf[t * 65 + dk]; const f32x4 c0 = *(const f32x4*)(Cs + dk * 64 + eg * 8), c1 = *(const f32x4*)(Cs + dk * 64 + eg * 8 + 4);
#pragma unroll
              for (int i = 0; i < 4; ++i) { n8[i] += qv * c0[i]; n8[4 + i] += qv * c1[i]; } }
#pragma unroll
          for (int i = 0; i < 8; ++i) n8[i] *= ebt;
#pragma unroll 2
          for (int s = 0; s < 64; ++s) { const float sv = Sm[t * 65 + s]; const f32x4 v0 = *(const f32x4*)(vf + s * 64 + eg * 8), v1 = *(const f32x4*)(vf + s * 64 + eg * 8 + 4);
#pragma unroll
              for (int i = 0; i < 4; ++i) { n8[i] += sv * v0[i]; n8[4 + i] += sv * v1[i]; } }
          const float idn = 1.f / fmaxf(fabsf(den), 1.f);
#pragma unroll
          for (int i = 0; i < 8; ++i) hacc[i] += n8[i] * idn; }
    }
    float ss = 0.f;
#pragma unroll
    for (int i = 0; i < 8; ++i) ss += hacc[i] * hacc[i];
    ss += __shfl_xor(ss, 1); ss += __shfl_xor(ss, 2); ss += __shfl_xor(ss, 4);
    const float rs = rsqrtf(ss * (1.f / 64.f) + EPS);
    bf16_t* up = c.U + (size_t)(rowbase + t) * UC + hh * 64 + eg * 8; float mo[8], o8[8]; ld8(up + UC_MO, mo);
    const float* on = c.in(I_MON) + l * 256 + hh * 64 + eg * 8;
#pragma unroll
    for (int i = 0; i < 8; ++i) o8[i] = sigmf(mo[i]) * (hacc[i] * rs * on[i]);
    st8(up + UC_MQ, o8);
}

__device__ __forceinline__ void ssd_out(const Ctx& c, int l, int b, int grp, int tc) {
    bf16_t* xin = (bf16_t*)c.lds; float* xc = (float*)(c.lds + 68 * 256 * 2); float* BT = xc + 64 * 128; float* Cc = BT + 64 * 68; float* G = Cc + 64 * 65; float* SpT = G + 64 * 65;
    float* cum = SpT + 4096; float* dtv = cum + 256;
    const bf16_t* STS = (const bf16_t*)(c.ws() + WS_STS);
    const int rowbase = chunk_row(b, tc);
    const int t = c.tid >> 3, pg = c.tid & 7;
    __syncthreads();
    ssd_conv<true>(c, l, b, grp, tc, xin, xc, BT, 68, 1, Cc);
    if (c.wave < 4) {
        const int hl = c.wave >> 1, d = c.wave & 1, h = grp * 2 + hl; float a, dt, pf, tot;
        ssd_gate(c, l, rowbase + c.lane, h, d, a, dt, pf, tot);
        cum[c.wave * 64 + c.lane] = d == 0 ? pf : (tot - pf + a); dtv[c.wave * 64 + c.lane] = dt;
    }
    __syncthreads();
    { float g8[8];
#pragma unroll
      for (int i = 0; i < 8; ++i) g8[i] = 0.f;
#pragma unroll 2
      for (int n = 0; n < 64; ++n) { const float cv = Cc[t * 65 + n]; const f32x4 b0 = *(const f32x4*)(BT + n * 68 + pg * 8), b1 = *(const f32x4*)(BT + n * 68 + pg * 8 + 4);
#pragma unroll
          for (int i = 0; i < 4; ++i) { g8[i] += cv * b0[i]; g8[4 + i] += cv * b1[i]; } }
#pragma unroll
      for (int i = 0; i < 8; ++i) G[t * 65 + pg * 8 + i] = g8[i]; }
    float yacc[2][8];
#pragma unroll
    for (int q = 0; q < 2; ++q)
#pragma unroll
        for (int i = 0; i < 8; ++i) yacc[q][i] = 0.f;
#pragma unroll
    for (int hl = 0; hl < 2; ++hl) {
#pragma unroll
        for (int d = 0; d < 2; ++d) {
            __syncthreads();
            { const bf16_t* st = STS + ((size_t)((b * 4 + grp * 2 + hl) * 2 + d) * NCH + scan_idx(d, tc)) * 4096; float s8[8]; ld8(st + c.tid * 8, s8);
#pragma unroll
              for (int i = 0; i < 8; ++i) SpT[c.tid * 8 + i] = s8[i]; }
            __syncthreads();
            const float* cm = cum + (hl * 2 + d) * 64; const float* dv = dtv + (hl * 2 + d) * 64;
            const float ct = cm[t], ect = __expf(ct);
            float y8[8];
#pragma unroll
            for (int i = 0; i < 8; ++i) y8[i] = 0.f;
#pragma unroll 2
            for (int n = 0; n < 64; ++n) { const float cv = Cc[t * 65 + n]; const f32x4 s0 = *(const f32x4*)(SpT + n * 64 + pg * 8), s1 = *(const f32x4*)(SpT + n * 64 + pg * 8 + 4);
#pragma unroll
                for (int i = 0; i < 4; ++i) { y8[i] += cv * s0[i]; y8[4 + i] += cv * s1[i]; } }
#pragma unroll
            for (int i = 0; i < 8; ++i) y8[i] *= ect;
            const int slo = d == 0 ? 0 : t, shi = d == 0 ? t : 63;
#pragma unroll 2
            for (int s = slo; s <= shi; ++s) {
                const float w = G[t * 65 + s] * __expf(ct - cm[s]) * dv[s];
                const f32x4 x0 = *(const f32x4*)(xc + s * 128 + hl * 64 + pg * 8), x1 = *(const f32x4*)(xc + s * 128 + hl * 64 + pg * 8 + 4);
#pragma unroll
                for (int i = 0; i < 4; ++i) { y8[i] += w * x0[i]; y8[4 + i] += w * x1[i]; }
            }
#pragma unroll
            for (int i = 0; i < 8; ++i) yacc[hl][i] += y8[i];
        }
    }
    float ss = 0.f; float g[2][8];
#pragma unroll
    for (int hl = 0; hl < 2; ++hl) {
        const int h = grp * 2 + hl; const float dsk = c.in(I_SD)[l * 4 + h];
        float z8[8]; ld8(c.U + (size_t)(rowbase + t) * UC + UC_SZ + h * 64 + pg * 8, z8);
#pragma unroll
        for (int i = 0; i < 8; ++i) { const float yy = yacc[hl][i] + dsk * xc[t * 128 + hl * 64 + pg * 8 + i]; g[hl][i] = yy * siluf(z8[i]); ss += g[hl][i] * g[hl][i]; }
    }
    ss += __shfl_xor(ss, 1); ss += __shfl_xor(ss, 2); ss += __shfl_xor(ss, 4);
    const float rs = rsqrtf(ss * (1.f / 128.f) + EPS);
#pragma unroll
    for (int hl = 0; hl < 2; ++hl) {
        const int h = grp * 2 + hl; const float* ng = c.in(I_SN) + l * 256 + h * 64 + pg * 8; float o8[8];
#pragma unroll
        for (int i = 0; i < 8; ++i) o8[i] = g[hl][i] * rs * ng[i];
        st8(c.U + (size_t)(rowbase + t) * UC + UC_SZ + h * 64 + pg * 8, o8);
    }
}

__device__ __forceinline__ void mix_x1_gemm(const Ctx& c, int l, pg8::StaticOrder& S) {
    pg8::Gemm g{c.U + UC_AQ, (const bf16_t*)(c.wb + WB_MLA), R, 1024, 384, UC};
    S.init(R, 1024, gridDim.x, blockIdx.x);
    EpiStore<1024, false> E{c.xn, nullptr}; pg8::gemm_phase(c.ldsl, c.tid, g, S, E);
}
__device__ __forceinline__ void mix_x1(const Ctx& c, int l) {
    constexpr int N_SWA = NB * NCH, N_ML = NB * 4 * NCH, N_SS = NB * 2 * NCH;
    for (int t = blockIdx.x; t < N_SWA + N_ML + N_SS; t += gridDim.x) {
        if (t < N_ML) { const int b = t / (4 * NCH), r = t % (4 * NCH); mlstm_local(c, l, b, r / NCH, r % NCH); }
        else if (t < N_ML + N_SS) { const int u = t - N_ML, b = u / (2 * NCH), r = u % (2 * NCH); ssd_local(c, l, b, r / NCH, r % NCH); }
        else { const int u = t - N_ML - N_SS; swa_prep(c, l, u / NCH, u % NCH); }
    }
}
__device__ __forceinline__ void mix_x2(const Ctx& c, int l) {
    constexpr int N_FIN = NB * NCH, N_SM = 128 * 5, N_SS = 128 * 4;
    for (int t = blockIdx.x; t < N_FIN + N_SM + N_SS; t += gridDim.x) {
        if (t < N_FIN) mla_finish(c, l, t / NCH, t % NCH);
        else if (t < N_FIN + N_SM) { const int u = t - N_FIN; scan_task(c, (bf16_t*)(c.ws() + WS_STM), (const float*)(c.ws() + WS_DECM), u / 5, 2080, u % 5); }
        else { const int u = t - N_FIN - N_SM; scan_task(c, (bf16_t*)(c.ws() + WS_STS), (const float*)(c.ws() + WS_DECS), u / 4, 2048, u % 4); }
    }
}
__device__ __forceinline__ void mix_x3(const Ctx& c, int l) {
    const bool last = (l == 1);
    const int nqb = last ? 16 : 18;
    const int tc0 = last ? 4 : 0, ntc = NCH - tc0;
    const int N_MLA = NB * 4 * nqb, N_SWA = NB * 4 * nqb, N_ML = NB * 4 * ntc, N_SS = NB * 2 * ntc;
    const bf16_t* QM = (const bf16_t*)(c.ws() + WS_QM); const bf16_t* KM = (const bf16_t*)(c.ws() + WS_KM); const bf16_t* VTM = (const bf16_t*)(c.ws() + WS_VTM);
    const bf16_t* Ksw = (const bf16_t*)(c.ws() + WS_KS); const bf16_t* Vts = (const bf16_t*)(c.ws() + WS_VTS);
    for (int t = blockIdx.x; t < N_MLA + N_SWA + N_ML + N_SS; t += gridDim.x) {
        if (t < N_MLA) {
            const int bh = t / nqb, qb = t % nqb, b = bh >> 2, h = bh & 3;
            const bool lat = qb < 16; const int qpos0 = lat ? 256 + qb * 128 : (qb - 16) * 128, row0 = lat ? b * TL + qb * 128 : RL + b * CL + (qb - 16) * 128;
            attn_task<96>(c, QM + ((size_t)bh * KEYS + qpos0) * 96, 96, KM + (size_t)bh * KEYS * 96, VTM + (size_t)bh * 64 * KEYS, lat ? 32 : 0, 4, false, 0,
                          0.10206207262f, 0.f, false, c.U + (size_t)row0 * UC + UC_AQ + h * 64, UC);
        } else if (t < N_MLA + N_SWA) {
            const int u = t - N_MLA, bh = u / nqb, qb = u % nqb, b = bh >> 2, h = bh & 3, kv = h >> 1;
            const bool lat = qb < 16; const int t0 = qb * 128, row0 = lat ? b * TL + t0 : RL + b * CL + (qb - 16) * 128;
            int lo = 0, hi = -1; if (lat) { lo = t0 >= 128 ? (t0 - 128) / 64 : 0; hi = (t0 + 255) / 64; if (hi > 31) hi = 31; }
            bf16_t* qo = c.U + (size_t)row0 * UC + UC_WQ + h * 64;
            attn_task<64>(c, qo, UC, Ksw + (size_t)(b * 2 + kv) * KEYS * 64, Vts + (size_t)(b * 2 + kv) * 64 * KEYS, hi - lo + 1, 4 + lo, true, t0,
                          0.125f, c.in(I_SINK)[l * 4 + h], true, qo, UC);
        } else if (t < N_MLA + N_SWA + N_SS) {
            const int u = t - N_MLA - N_SWA, b = u / (2 * ntc), r = u % (2 * ntc); ssd_out(c, l, b, r / ntc, tc0 + r % ntc);
        } else {
            const int u = t - N_MLA - N_SWA - N_SS, b = u / (4 * ntc), r = u % (4 * ntc); mlstm_out(c, l, b, r / ntc, tc0 + r % ntc);
        }
    }
}
#endif

template <int L, int PT>
__device__ __forceinline__ void do_phase(Ctx& c, const int wv) {
    { int lane; asm volatile("v_mbcnt_lo_u32_b32 %0, -1, 0\n\tv_mbcnt_hi_u32_b32 %0, -1, %0" : "=v"(lane));
      c.lane = lane; c.wave = wv; c.tid = wv * 64 + lane;
      unsigned char* ws = c.ws();
      c.hc = (float*)(ws + WS_HC); c.mod = (float*)(ws + WS_MOD); c.gates = (float*)(ws + WS_GATES); c.wb = ws + WS_WB; c.xn = (bf16_t*)(ws + WS_XN); c.U = (bf16_t*)(ws + WS_U); }
    if constexpr (PT < 0) { mod_phase(c); conv_phase(c, 0); }
    else {
        constexpr int l = L, pt = PT;
        constexpr bool last = (l == 1);
        pg8::StaticOrder S;
        const float* modl = c.mod + (size_t)l * 17 * 9216;
        const float* hl = (l == 0 && pt <= 2) ? c.in(I_X) : c.out();
        const float* hcs = (l == 0 && pt <= 2) ? c.in(I_CTX) : c.hc;
        if constexpr (pt == 0) { if (l > 0) conv_phase(c, l); norm_phase(c, hl, hcs, R, c.in(I_F1N) + l * 1024, modl, 0, 1); }
        else if constexpr (pt == 3) norm_phase(c, hl, hcs, R, c.in(I_MIXN) + l * 1024, modl, 3, 4);
        else if constexpr (pt == 9) norm_phase(c, hl, hcs, last ? RL : R, c.in(I_F2N) + l * 1024, modl, 6, 7);
        else if constexpr (pt == 1 || pt == 10) {
            constexpr int M = (pt == 10 && last) ? RL : R;
            pg8::Gemm g{c.xn, (const bf16_t*)(c.wb + (pt == 1 ? WB_WI1 : WB_WI2)), M, 5632, 1024, 1024};
            S.init(M, 5632, gridDim.x, blockIdx.x);
            EpiSwiglu E{c.U}; pg8::gemm_phase(c.ldsl, c.tid, g, S, E); }
        else if constexpr (pt == 2 || pt == 11) {
            constexpr int M = (pt == 11 && last) ? RL : R;
            pg8::Gemm g{c.U, (const bf16_t*)(c.wb + (pt == 2 ? WB_WO1 : WB_WO2)), M, 1024, 2816, 2816};
            S.init(M, 1024, gridDim.x, blockIdx.x);
            EpiResid E{hl, hcs, c.out(), c.hc, modl, pt == 2 ? 2 : 8, 0.5f}; pg8::gemm_phase(c.ldsl, c.tid, g, S, E); }
        else if constexpr (pt == 4) {
            pg8::Gemm g{c.xn, (const bf16_t*)(c.wb + WB_WIN), R, 2816, 1024, 1024};
            S.init(R, 2816, gridDim.x, blockIdx.x);
            EpiStore<UC, true> E{c.U, c.gates}; pg8::gemm_phase(c.ldsl, c.tid, g, S, E); }
#if N_MIX
        else if constexpr (pt == 5) mix_x1_gemm(c, l, S);
        else if constexpr (pt == 12) mix_x1(c, l);
        else if constexpr (pt == 6) mix_x2(c, l);
        else if constexpr (pt == 7) mix_x3(c, l);
        else if constexpr (pt == 8) {
            constexpr int M = last ? RL : R;
            pg8::Gemm g{c.U, (const bf16_t*)(c.wb + WB_WOUT), M, 1024, 1024, UC};
            S.init(M, 1024, gridDim.x, blockIdx.x);
            EpiResid E{hl, hcs, c.out(), c.hc, modl, 5, 1.0f}; pg8::gemm_phase(c.ldsl, c.tid, g, S, E); }
#endif
    }
}

__global__ void __launch_bounds__(NTHR, 2) mega(Params p) {
    extern __shared__ __attribute__((aligned(16))) unsigned char smem[];
    cg::grid_group grid = cg::this_grid();
    Ctx c; c.lds = smem; c.ldsl = (LAS unsigned char*)smem;
    { LAS unsigned long long* pl = (LAS unsigned long long*)(c.ldsl + PARAM_OFF); const int t0 = threadIdx.x;
      if (t0 < 32) pl[t0] = (unsigned long long)p.in[t0]; else if (t0 == 32) pl[32] = (unsigned long long)p.out; else if (t0 == 33) pl[33] = (unsigned long long)p.ws; }
    __syncthreads();
    const int ph_lo = p.ph_lo, ph_hi = p.ph_hi;
    const int wv = __builtin_amdgcn_readfirstlane(threadIdx.x >> 6);
#define RUN(PH, L, PT) if (ph_lo <= (PH) && (PH) < ph_hi) { do_phase<L, PT>(c, wv); if (PT == 5) do_phase<L, 12>(c, wv); if ((PH) + 1 < ph_hi) grid.sync(); }
    RUN(0, 0, -1)
    RUN(1, 0, 0) RUN(2, 0, 1) RUN(3, 0, 2) RUN(4, 0, 3) RUN(5, 0, 4) RUN(6, 0, 5) RUN(7, 0, 6) RUN(8, 0, 7) RUN(9, 0, 8) RUN(10, 0, 9) RUN(11, 0, 10) RUN(12, 0, 11)
    RUN(13, 1, 0) RUN(14, 1, 1) RUN(15, 1, 2) RUN(16, 1, 3) RUN(17, 1, 4) RUN(18, 1, 5) RUN(19, 1, 6) RUN(20, 1, 7) RUN(21, 1, 8) RUN(22, 1, 9) RUN(23, 1, 10) RUN(24, 1, 11)
#undef RUN
}

extern "C" void kernel_launch(void* const* d_in, const int* in_sizes, int n_in, void* d_out, int out_size, void* d_ws, size_t ws_size, hipStream_t stream) {
    static int grid = 0;
    if (grid == 0) {
        if (n_in != 32 || ws_size < WS_END) { fprintf(stderr, "kernel_launch: unexpected n_in %d / ws_size %zu (need %zu)\n", n_in, ws_size, (size_t)WS_END); grid = -1; return; }
        int dev = 0, cus = 0, per_cu = 0;
        hipGetDevice(&dev);
        hipDeviceGetAttribute(&cus, hipDeviceAttributeMultiprocessorCount, dev);
        hipFuncSetAttribute((const void*)mega, hipFuncAttributeMaxDynamicSharedMemorySize, LDS_BYTES);
        hipOccupancyMaxActiveBlocksPerMultiprocessor(&per_cu, (const void*)mega, NTHR, LDS_BYTES);
        if (per_cu < 1) per_cu = 1;
        grid = cus;
        (void)hipGetLastError();
    }
    if (grid < 0) return;
    Params p{};
    for (int i = 0; i < 32; ++i) p.in[i] = (const float*)d_in[i];
    p.out = (float*)d_out; p.ws = (unsigned char*)d_ws; p.ph_lo = 0; p.ph_hi = 25;
    void* args[] = {&p};
    hipError_t e = hipLaunchCooperativeKernel((const void*)mega, dim3(grid), dim3(NTHR), args, LDS_BYTES, stream);
    if (e != hipSuccess) fprintf(stderr, "cooperative launch failed: %s (grid %d)\n", hipGetErrorString(e), grid);
}
```

```cpp
#include <hip/hip_runtime.h>
#include <hip/hip_cooperative_groups.h>
#include <cstdio>
#include <cstdint>
namespace cg = cooperative_groups;

#define LAS __attribute__((address_space(3)))
typedef unsigned short bf16_t;
typedef short bf16x8 __attribute__((ext_vector_type(8)));
typedef float f32x4 __attribute__((ext_vector_type(4)));
typedef unsigned u32x4 __attribute__((ext_vector_type(4)));
typedef unsigned u32x2 __attribute__((ext_vector_type(2)));

#ifndef N_MIX
#define N_MIX 1
#endif

constexpr int D = 1024, NB = 16, TL = 2048, CL = 256, RL = NB * TL, RC = NB * CL, R = RL + RC;
constexpr int FF = 2816, UC = 2816, KEYS = CL + TL, NCH = KEYS / 64;
constexpr float EPS = 1e-6f;
constexpr int NTHR = 512;
constexpr int LDS_BYTES = 147456;
constexpr int UC_MQ = 0, UC_WQ = 256, UC_SZ = 512, UC_AQ = 768, UC_AKV = 1024, UC_AKR = 1152, UC_MK = 1184, UC_MV = 1440, UC_MO = 1696,
              UC_WK = 1952, UC_WV = 2080, UC_XBC = 2208, UC_MG = 2720, UC_DT = 2736;
constexpr size_t WS_HC = 0;
constexpr size_t WS_MOD = WS_HC + (size_t)RC * D * 4;
constexpr size_t WS_GATES = WS_MOD + (size_t)2 * 17 * 9216 * 4;
constexpr size_t WS_WB = WS_GATES + (size_t)R * 32 * 4;
constexpr size_t WB_WI1 = 0, WB_WO1 = WB_WI1 + (size_t)5632 * 1024 * 2, WB_WIN = WB_WO1 + (size_t)1024 * 2816 * 2, WB_WOUT = WB_WIN + (size_t)2816 * 1024 * 2,
                 WB_WI2 = WB_WOUT + (size_t)1024 * 1024 * 2, WB_WO2 = WB_WI2 + (size_t)5632 * 1024 * 2, WB_MLA = WB_WO2 + (size_t)1024 * 2816 * 2, WB_END = WB_MLA + (size_t)1024 * 384 * 2;
constexpr size_t WS_XN = WS_WB + WB_END;
constexpr size_t WS_U = WS_XN + (size_t)R * 1024 * 2;
constexpr size_t WS_STM = WS_U + (size_t)R * UC * 2;
constexpr size_t WS_STS = WS_STM + (size_t)NB * 4 * 2 * NCH * 4160 * 2;
constexpr size_t WS_DECM = WS_STS + (size_t)NB * 4 * 2 * NCH * 4096 * 2;
constexpr size_t WS_DECS = WS_DECM + (size_t)NB * 4 * 2 * NCH * 4;
constexpr size_t WS_QM = WS_DECS + (size_t)NB * 4 * 2 * NCH * 4;
constexpr size_t WS_KM = WS_QM + (size_t)NB * 4 * KEYS * 96 * 2;
constexpr size_t WS_VTM = WS_KM + (size_t)NB * 4 * KEYS * 96 * 2;
constexpr size_t WS_KS = WS_VTM + (size_t)NB * 4 * 64 * KEYS * 2;
constexpr size_t WS_VTS = WS_KS + (size_t)NB * 2 * KEYS * 64 * 2;
constexpr size_t WS_BAR = WS_VTS + (size_t)NB * 2 * 64 * KEYS * 2;
constexpr size_t WS_END = WS_BAR + 16384;

struct Params { const float* in[32]; float* out; unsigned char* ws; int ph_lo, ph_hi; };
enum { I_X = 0, I_C, I_CTX, I_CCTX, I_WMOD, I_BMOD, I_F1N, I_F1WI, I_F1WO, I_MIXN, I_WIN, I_WOUT, I_MGB, I_MON, I_AQN, I_AKVN, I_AWQ, I_AWKV, I_AQG, I_AKG,
       I_SQG, I_SKG, I_SINK, I_CW, I_CB, I_DTB, I_ALOG, I_SD, I_SN, I_F2N, I_F2WI, I_F2WO };

__device__ __forceinline__ float bf2f(bf16_t v) { return __uint_as_float((unsigned)v << 16); }
__device__ __forceinline__ bf16_t f2bf(float f) { unsigned u = __float_as_uint(f); return (bf16_t)((u + 0x7fffu + ((u >> 16) & 1u)) >> 16); }
typedef float f32x2_t __attribute__((ext_vector_type(2)));
typedef __bf16 bf16x2_t __attribute__((ext_vector_type(2)));
__device__ __forceinline__ unsigned pk2(float lo, float hi) { const f32x2_t v = {lo, hi}; const bf16x2_t b = __builtin_convertvector(v, bf16x2_t); return __builtin_bit_cast(unsigned, b); }
template <int CTRL> __device__ __forceinline__ float dppf(float v) { return __int_as_float(__builtin_amdgcn_update_dpp(0, __float_as_int(v), CTRL, 0xf, 0xf, true)); }
__device__ __forceinline__ float row16_max(float v) { v = fmaxf(v, dppf<0x128>(v)); v = fmaxf(v, dppf<0x124>(v)); v = fmaxf(v, dppf<0x122>(v)); return fmaxf(v, dppf<0x121>(v)); }
__device__ __forceinline__ float row16_sum(float v) { v += dppf<0x128>(v); v += dppf<0x124>(v); v += dppf<0x122>(v); return v + dppf<0x121>(v); }
__device__ __forceinline__ float wave_sum(float v) {
    v = row16_sum(v); v += __shfl_xor(v, 16); v += __shfl_xor(v, 32); return v;
}
__device__ __forceinline__ float siluf(float x) { return x * __builtin_amdgcn_rcpf(1.f + __builtin_amdgcn_exp2f(x * -1.44269504089f)); }
__device__ __forceinline__ float sigmf(float x) { return __builtin_amdgcn_rcpf(1.f + __builtin_amdgcn_exp2f(x * -1.44269504089f)); }
__device__ __forceinline__ float logsigf(float x) { return fminf(x, 0.f) - log1pf(__expf(-fabsf(x))); }
__device__ __forceinline__ float softplusf(float x) { return fmaxf(x, 0.f) + log1pf(__expf(-fabsf(x))); }

namespace pg8 {
constexpr int BM = 256, BK = 64, HALF = 128, HTB = HALF * BK * 2, STAGE_BYTES = 8 * HTB, NXCD = 8, WGM = 8;
__host__ __device__ __forceinline__ int lds_byte(int r, int c) { const int st = (r >> 4) * 2 + (c >> 5), rr = r & 15, cc = c & 31, ob = rr * 64 + cc * 2; return st * 1024 + (ob ^ (((ob >> 9) & 1) << 5)); }
__host__ __device__ __forceinline__ void stage_rc(int b, int& Rr, int& C) { const int st = b / 1024, sb = b % 1024, swz = sb ^ (((sb >> 9) & 1) << 5); Rr = (st >> 1) * 16 + swz / 64; C = (st & 1) * 32 + (swz % 64) / 2; }
__host__ __device__ __forceinline__ int perm32(int rho) { const int n = rho >> 4, i = rho & 15; return 8 * (i >> 2) + 4 * n + (i & 3); }
struct Unit { int pm, pn; };
struct Gemm { const bf16_t* A; const bf16_t* Bt; int M, N, K, lda; };
struct StaticOrder {
    int nM, nN, nwg, G, c;
    __device__ void init(int M, int N, int G_, int c_) { nM = M / BM; nN = N / BM; nwg = nM * nN; G = G_; c = c_; }
    __device__ bool next(int i, Unit& u) const {
        const long L = (long)i * G + c; if (L >= nwg) return false;
        int wgid = (int)L; { const int q = nwg / NXCD, r = nwg % NXCD, xcd = wgid % NXCD, off = wgid / NXCD; wgid = (xcd < r ? xcd * (q + 1) : r * (q + 1) + (xcd - r) * q) + off; }
        const int nig = WGM * nN, gid = wgid / nig, fm = gid * WGM, gsz = (nM - fm) < WGM ? (nM - fm) : WGM;
        u.pm = fm + ((wgid % nig) % gsz); u.pn = (wgid % nig) / gsz; return true;
    }
};
template <class Epi, bool SP2 = true, bool ALIGN_EPI = true>
__device__ __forceinline__ void gemm_phase(LAS unsigned char* lds, const int tid, const Gemm g, const StaticOrder& S, const Epi& E) {
    const int wid = __builtin_amdgcn_readfirstlane(tid >> 6), lane = tid & 63, wr = wid >> 2, wc = wid & 3, fr = lane & 15, fq = lane >> 4;
    const int K = g.K, nt = K / BK, lda = g.lda;
    unsigned voffA_, voffB_;
    { int Rr, C; stage_rc(tid * 16, Rr, C); const int Rb = Epi::PERM ? ((Rr & ~31) + perm32(Rr & 31)) : Rr;
      voffA_ = (unsigned)(Rr * lda + C) * 2u; voffB_ = (unsigned)(Rb * K + C) * 2u; }
    const unsigned v_offA = voffA_, v_offB = voffB_;
    const size_t r64offA = (size_t)64 * lda * 2, r64offB = (size_t)64 * K * 2;
    const size_t kstep = (size_t)(BK * 2);
    const size_t hstepA = (size_t)HALF * lda * 2, hstepB = (size_t)HALF * K * 2;
    const size_t tstepA = 2 * hstepA, tstepB = 2 * hstepB;
    const unsigned ldsw = (unsigned)wid * 1024u;
    const int aoff = lds_byte(wr * 64 + fr, fq * 8), boff = lds_byte(wc * 32 + fr, fq * 8);
#define PG8_SA(b, h) (((b) * 2 + (h)) * HTB)
#define PG8_SB(b, h) ((4 + (b) * 2 + (h)) * HTB)
#define PG8_STAGE(bufoff, gbase, voff) do { _Pragma("unroll") for (int _i = 0; _i < 2; ++_i) \
        __builtin_amdgcn_global_load_lds((const unsigned*)((const char*)(gbase) + _i * r64##voff + v_##voff), (LAS unsigned*)(lds + (bufoff) + ldsw + _i * 8192), 16, 0, 0); } while (0)
#define PG8_LDA(dst, b, h) do { _Pragma("unroll") for (int m = 0; m < 4; ++m) _Pragma("unroll") for (int k = 0; k < 2; ++k) dst[m][k] = *(const LAS bf16x8*)(lds + PG8_SA(b, h) + aoff + m * 2048 + k * 1024); } while (0)
#define PG8_LDB(dst, b, h) do { _Pragma("unroll") for (int n = 0; n < 2; ++n) _Pragma("unroll") for (int k = 0; k < 2; ++k) dst[n][k] = *(const LAS bf16x8*)(lds + PG8_SB(b, h) + boff + n * 2048 + k * 1024); } while (0)
#define PG8_MMA(ai, bj, At, Bt) do { __builtin_amdgcn_s_setprio(1); _Pragma("unroll") for (int m = 0; m < 4; ++m) _Pragma("unroll") for (int n = 0; n < 2; ++n) _Pragma("unroll") for (int k = 0; k < 2; ++k) \
        acc[ai][bj][m][n] = __builtin_amdgcn_mfma_f32_16x16x32_bf16(Bt[n][k], At[m][k], acc[ai][bj][m][n], 0, 0, 0); __builtin_amdgcn_s_setprio(0); } while (0)
#define PG8_WAIT_V(n) asm volatile("s_waitcnt vmcnt(" #n ")" ::: "memory")
#define PG8_WAIT_L(n) asm volatile("s_waitcnt lgkmcnt(" #n ")" ::: "memory")
#define PG8_BAR __builtin_amdgcn_s_barrier()
#define PG8_SCHED __builtin_amdgcn_sched_barrier(0)
    Unit cur, nxt; int ui = 0;
    if (!S.next(0, cur)) return;
    f32x4 acc[2][2][4][2];
#pragma unroll
    for (int a = 0; a < 2; ++a)
#pragma unroll
        for (int b = 0; b < 2; ++b)
#pragma unroll
            for (int m = 0; m < 4; ++m)
#pragma unroll
                for (int n = 0; n < 2; ++n) acc[a][b][m][n] = (f32x4){0.f, 0.f, 0.f, 0.f};
    bf16x8 At[4][2], B0[2][2], B1[2][2];
    const char* cA = (const char*)g.A + (size_t)cur.pm * tstepA; const char* cB = (const char*)g.Bt + (size_t)cur.pn * tstepB;
    if constexpr (SP2) {
        PG8_STAGE(PG8_SB(0, 0), cB, offB); PG8_STAGE(PG8_SB(0, 1), cB + hstepB, offB); PG8_STAGE(PG8_SA(0, 0), cA, offA); PG8_STAGE(PG8_SA(0, 1), cA + hstepA, offA);
        if (wr == 1) PG8_BAR;
        PG8_WAIT_V(2); PG8_BAR;
        PG8_STAGE(PG8_SB(1, 0), cB + kstep, offB); PG8_STAGE(PG8_SA(1, 0), cA + kstep, offA); PG8_STAGE(PG8_SB(1, 1), cB + hstepB + kstep, offB);
        PG8_WAIT_V(6); PG8_BAR;
    } else {
    PG8_STAGE(PG8_SB(0, 0), cB, offB); PG8_STAGE(PG8_SA(0, 0), cA, offA); PG8_STAGE(PG8_SB(0, 1), cB + hstepB, offB); PG8_STAGE(PG8_SA(0, 1), cA + hstepA, offA);
    if (wr == 1) PG8_BAR;
    PG8_WAIT_V(4); PG8_BAR;
    PG8_STAGE(PG8_SB(1, 0), cB + kstep, offB); PG8_STAGE(PG8_SA(1, 0), cA + kstep, offA); PG8_STAGE(PG8_SB(1, 1), cB + hstepB + kstep, offB);
    PG8_WAIT_V(6); PG8_BAR;
    }
    for (;;) {
        const bool has_next = S.next(ui + 1, nxt);
        const char* nA = has_next ? (const char*)g.A + (size_t)nxt.pm * tstepA : cA; const char* nB = has_next ? (const char*)g.Bt + (size_t)nxt.pn * tstepB : cB;
        for (int t = 0; t < nt; t += 2) {
            const bool last = (t == nt - 2);
            const char* a1 = cA + (size_t)(t + 1) * kstep;
            const char* a2 = last ? nA : cA + (size_t)(t + 2) * kstep; const char* b2 = last ? nB : cB + (size_t)(t + 2) * kstep;
            const char* a3 = a2 + kstep; const char* b3 = b2 + kstep;
            if constexpr (SP2) {
            PG8_LDB(B0, 0, 0); PG8_LDB(B1, 0, 1); PG8_SCHED; PG8_LDA(At, 0, 0); PG8_STAGE(PG8_SA(1, 1), a1 + hstepA, offA);
            PG8_WAIT_V(8); PG8_WAIT_L(0); PG8_BAR; PG8_MMA(0, 0, At, B0); PG8_MMA(0, 1, At, B1); PG8_BAR; PG8_SCHED;
            PG8_LDA(At, 0, 1); PG8_STAGE(PG8_SB(0, 0), b2, offB); PG8_STAGE(PG8_SB(0, 1), b2 + hstepB, offB); PG8_STAGE(PG8_SA(0, 0), a2, offA);
            PG8_WAIT_V(8); PG8_WAIT_L(0); PG8_BAR; PG8_MMA(1, 0, At, B0); PG8_MMA(1, 1, At, B1); PG8_BAR; PG8_SCHED;
            PG8_LDB(B0, 1, 0); PG8_LDB(B1, 1, 1); PG8_SCHED; PG8_LDA(At, 1, 0); PG8_STAGE(PG8_SA(0, 1), a2 + hstepA, offA);
            PG8_WAIT_V(8); PG8_WAIT_L(0); PG8_BAR; PG8_MMA(0, 0, At, B0); PG8_MMA(0, 1, At, B1); PG8_BAR; PG8_SCHED;
            PG8_LDA(At, 1, 1); PG8_STAGE(PG8_SB(1, 0), b3, offB); PG8_STAGE(PG8_SB(1, 1), b3 + hstepB, offB); PG8_STAGE(PG8_SA(1, 0), a3, offA);
            PG8_WAIT_V(8); PG8_WAIT_L(0); PG8_BAR; PG8_MMA(1, 0, At, B0); PG8_MMA(1, 1, At, B1); PG8_BAR; PG8_SCHED;
            } else {
            PG8_LDB(B0, 0, 0); PG8_SCHED; PG8_LDA(At, 0, 0); PG8_STAGE(PG8_SA(1, 1), a1 + hstepA, offA);
            PG8_WAIT_L(8); PG8_BAR; PG8_WAIT_L(0); PG8_MMA(0, 0, At, B0); PG8_BAR; PG8_SCHED;
            PG8_LDB(B1, 0, 1); PG8_STAGE(PG8_SB(0, 0), b2, offB);
            PG8_BAR; PG8_WAIT_L(0); PG8_MMA(0, 1, At, B1); PG8_BAR;
            PG8_LDA(At, 0, 1); PG8_STAGE(PG8_SA(0, 0), a2, offA);
            PG8_BAR; PG8_WAIT_L(0); PG8_MMA(1, 0, At, B0); PG8_BAR; PG8_SCHED;
            PG8_STAGE(PG8_SB(0, 1), b2 + hstepB, offB);
            PG8_WAIT_V(6); PG8_BAR; PG8_MMA(1, 1, At, B1); PG8_BAR;
            PG8_LDB(B0, 1, 0); PG8_SCHED; PG8_LDA(At, 1, 0); PG8_STAGE(PG8_SA(0, 1), a2 + hstepA, offA);
            PG8_WAIT_L(8); PG8_BAR; PG8_WAIT_L(0); PG8_MMA(0, 0, At, B0); PG8_BAR; PG8_SCHED;
            PG8_LDB(B1, 1, 1); PG8_STAGE(PG8_SB(1, 0), b3, offB);
            PG8_BAR; PG8_WAIT_L(0); PG8_MMA(0, 1, At, B1); PG8_BAR;
            PG8_LDA(At, 1, 1); PG8_STAGE(PG8_SA(1, 0), a3, offA);
            PG8_BAR; PG8_WAIT_L(0); PG8_MMA(1, 0, At, B0); PG8_BAR; PG8_SCHED;
            PG8_STAGE(PG8_SB(1, 1), b3 + hstepB, offB);
            PG8_WAIT_V(6); PG8_BAR; PG8_MMA(1, 1, At, B1); PG8_BAR;
            }
        }
        if constexpr (ALIGN_EPI) { if (wr == 0) PG8_BAR; }
        E(acc, cur, wr, wc, fr, fq);
        if (!has_next) break;
#pragma unroll
        for (int a = 0; a < 2; ++a)
#pragma unroll
            for (int b = 0; b < 2; ++b)
#pragma unroll
                for (int m = 0; m < 4; ++m)
#pragma unroll
                    for (int n = 0; n < 2; ++n) acc[a][b][m][n] = (f32x4){0.f, 0.f, 0.f, 0.f};
        cur = nxt; cA = nA; cB = nB; ++ui;
        if constexpr (ALIGN_EPI) { if (wr == 1) PG8_BAR; }
    }
    PG8_WAIT_V(0);
    if constexpr (!ALIGN_EPI) { if (wr == 0) PG8_BAR; }
    PG8_BAR;
#undef PG8_SA
#undef PG8_SB
#undef PG8_STAGE
#undef PG8_LDA
#undef PG8_LDB
#undef PG8_MMA
#undef PG8_WAIT_V
#undef PG8_WAIT_L
#undef PG8_BAR
#undef PG8_SCHED
}
}

struct EpiSwiglu {
    static constexpr bool PERM = true;
    bf16_t* act;
    __device__ __forceinline__ void operator()(const f32x4 (&acc)[2][2][4][2], const pg8::Unit& u, int wr, int wc, int fr, int fq) const {
        const int row0 = u.pm * 256 + wr * 64 + fr, col0 = u.pn * 128 + wc * 32 + 8 * fq;
#pragma unroll
        for (int ai = 0; ai < 2; ++ai)
#pragma unroll
            for (int m = 0; m < 4; ++m) {
                bf16_t* rowp = act + (size_t)(row0 + ai * 128 + m * 16) * FF + col0;
                const f32x4 g0 = acc[ai][0][m][0], g1 = acc[ai][0][m][1], u0 = acc[ai][1][m][0], u1 = acc[ai][1][m][1];
                u32x4 w;
                w.x = pk2(siluf(g0[0]) * u0[0], siluf(g0[1]) * u0[1]); w.y = pk2(siluf(g0[2]) * u0[2], siluf(g0[3]) * u0[3]);
                w.z = pk2(siluf(g1[0]) * u1[0], siluf(g1[1]) * u1[1]); w.w = pk2(siluf(g1[2]) * u1[2], siluf(g1[3]) * u1[3]);
                *(u32x4*)rowp = w;
            }
    }
};
struct EpiResid {
    static constexpr bool PERM = false;
    const float* srcl; const float* srcc; float* dstl; float* dstc; const float* mod; int gi; float sc;
    __device__ __forceinline__ void operator()(const f32x4 (&acc)[2][2][4][2], const pg8::Unit& u, int wr, int wc, int fr, int fq) const {
        const int row0 = u.pm * 256 + wr * 64 + fr;
        const bool lat = u.pm < (RL / 256);
        const int bi = lat ? (u.pm >> 3) : 16;
        const float* g = mod + (size_t)(bi * 9 + gi) * 1024 + u.pn * 256 + wc * 32 + fq * 4;
        const size_t ro = (lat ? (size_t)row0 : (size_t)(row0 - RL)) * 1024 + u.pn * 256 + wc * 32 + fq * 4;
        const float* sp = (lat ? srcl : srcc) + ro; float* dp = (lat ? dstl : dstc) + ro;
        f32x4 gg[2][2];
#pragma unroll
        for (int bj = 0; bj < 2; ++bj)
#pragma unroll
            for (int n = 0; n < 2; ++n) gg[bj][n] = *(const f32x4*)(g + bj * 128 + n * 16) * sc;
#pragma unroll
        for (int ai = 0; ai < 2; ++ai) {
            f32x4 h[4][2][2];
#pragma unroll
            for (int m = 0; m < 4; ++m)
#pragma unroll
                for (int bj = 0; bj < 2; ++bj)
#pragma unroll
                    for (int n = 0; n < 2; ++n) h[m][bj][n] = *(const f32x4*)(sp + (size_t)(ai * 128 + m * 16) * 1024 + bj * 128 + n * 16);
#pragma unroll
            for (int m = 0; m < 4; ++m)
#pragma unroll
                for (int bj = 0; bj < 2; ++bj)
#pragma unroll
                    for (int n = 0; n < 2; ++n) *(f32x4*)(dp + (size_t)(ai * 128 + m * 16) * 1024 + bj * 128 + n * 16) = h[m][bj][n] + gg[bj][n] * acc[ai][bj][m][n];
        }
    }
};
template <int LDC, bool GATES>
struct EpiStore {
    static constexpr bool PERM = true;
    bf16_t* O; float* gates;
    __device__ __forceinline__ void operator()(const f32x4 (&acc)[2][2][4][2], const pg8::Unit& u, int wr, int wc, int fr, int fq) const {
        const int row0 = u.pm * 256 + wr * 64 + fr, col0 = u.pn * 256 + wc * 32 + 8 * fq;
        bf16_t* base = O + (size_t)row0 * LDC + col0;
#pragma unroll
        for (int ai = 0; ai < 2; ++ai)
#pragma unroll
            for (int m = 0; m < 4; ++m) {
#pragma unroll
                for (int bj = 0; bj < 2; ++bj) {
                    const f32x4 v0 = acc[ai][bj][m][0], v1 = acc[ai][bj][m][1];
                    u32x4 w; w.x = pk2(v0[0], v0[1]); w.y = pk2(v0[2], v0[3]); w.z = pk2(v1[0], v1[1]); w.w = pk2(v1[2], v1[3]);
                    *(u32x4*)(base + (ai * 128 + m * 16) * LDC + bj * 128) = w;
                }
            }
        if (GATES) {
            if (u.pn == 10 && wc == 1 && fq < 3) {
                float* gp = gates + (size_t)row0 * 32 + 8 * fq;
#pragma unroll
                for (int ai = 0; ai < 2; ++ai)
#pragma unroll
                    for (int m = 0; m < 4; ++m) { *(f32x4*)(gp + (ai * 128 + m * 16) * 32) = acc[ai][1][m][0]; *(f32x4*)(gp + (ai * 128 + m * 16) * 32 + 4) = acc[ai][1][m][1]; }
            }
        }
    }
};
static_assert(UC_MG == 2560 + 128 + 32, "gate columns sit at tile 10, bj 1, wc 1");

constexpr int PARAM_OFF = LDS_BYTES - 512;
struct Ctx {
    unsigned char* lds; LAS unsigned char* ldsl; int tid, lane, wave;
    float* hc; float* mod; float* gates; unsigned char* wb; bf16_t* xn; bf16_t* U;
    __device__ __forceinline__ unsigned long long ptr(int i) const {
        const LAS unsigned* q = (const LAS unsigned*)(ldsl + PARAM_OFF) + 2 * i;
        const unsigned lo = __builtin_amdgcn_readfirstlane(q[0]), hi = __builtin_amdgcn_readfirstlane(q[1]);
        return ((unsigned long long)hi << 32) | lo; }
    __device__ __forceinline__ const float* in(int i) const { return (const float*)ptr(i); }
    __device__ __forceinline__ float* out() const { return (float*)ptr(32); }
    __device__ __forceinline__ unsigned char* ws() const { return (unsigned char*)ptr(33); }
};

__device__ __forceinline__ Ctx retask(const Ctx& c) {
    Ctx r = c; int lane; asm volatile("v_mbcnt_lo_u32_b32 %0, -1, 0\n\tv_mbcnt_hi_u32_b32 %0, -1, %0" : "=v"(lane));
    r.lane = lane; r.tid = c.wave * 64 + lane; return r;
}

__device__ __forceinline__ void mod_phase(const Ctx& c) {
    float* sc = (float*)c.lds;
    float* red = sc + 17 * 1024;
    const float* cv = c.in(I_C); const float* cc = c.in(I_CCTX);
    for (int i = c.tid; i < 17 * 1024; i += NTHR) { const int bi = i >> 10, k = i & 1023; const float v = bi < 16 ? cv[bi * 1024 + k] : cc[k]; sc[i] = siluf(v); }
    __syncthreads();
    for (int task = blockIdx.x; task < 288; task += gridDim.x) {
        const int l = task / 144, cgp = task % 144;
        const float* w = c.in(I_WMOD) + (size_t)l * 1024 * 9216 + cgp * 64 + c.lane;
        float acc[17];
#pragma unroll
        for (int b = 0; b < 17; ++b) acc[b] = 0.f;
#pragma unroll 8
        for (int kk = 0; kk < 128; ++kk) {
            const int k = c.wave * 128 + kk; const float wv = w[(size_t)k * 9216];
#pragma unroll
            for (int b = 0; b < 17; ++b) acc[b] += sc[b * 1024 + k] * wv;
        }
#pragma unroll
        for (int b = 0; b < 17; ++b) red[(c.wave * 17 + b) * 64 + c.lane] = acc[b];
        __syncthreads();
        for (int o = c.tid; o < 17 * 64; o += NTHR) {
            const int b = o >> 6, ln = o & 63; float s = 0.f;
#pragma unroll
            for (int wv = 0; wv < 8; ++wv) s += red[(wv * 17 + b) * 64 + ln];
            s += c.in(I_BMOD)[l * 9216 + cgp * 64 + ln];
            c.mod[(size_t)(l * 17 + b) * 9216 + cgp * 64 + ln] = s;
        }
        __syncthreads();
    }
}

template <class F>
__device__ __forceinline__ void conv_job(const Ctx& c, bf16_t* Bt, int K, int Ndst, F src, int& rot) {
    float* tile = (float*)c.lds;
    const int nk = K / 64, nn = Ndst / 64, total = nk * nn;
    const int ln = c.tid & 63, lk = c.tid >> 6;
    const int sn = c.tid >> 3, sk = c.tid & 7;
    float r[8];
    int t = ((int)blockIdx.x + (int)gridDim.x - rot) % (int)gridDim.x;
    rot = (rot + total) % (int)gridDim.x;
    if (t < total) { const int n0 = (t / nk) * 64, k0 = (t % nk) * 64;
#pragma unroll
        for (int e = 0; e < 8; ++e) r[e] = src(n0 + ln, k0 + lk + 8 * e); }
    for (; t < total; t += gridDim.x) {
        const int n0 = (t / nk) * 64, k0 = (t % nk) * 64;
        __syncthreads();
#pragma unroll
        for (int e = 0; e < 8; ++e) tile[(lk + 8 * e) * 65 + ln] = r[e];
        __syncthreads();
        const int tn = t + gridDim.x;
        if (tn < total) { const int n1 = (tn / nk) * 64, k1 = (tn % nk) * 64;
#pragma unroll
            for (int e = 0; e < 8; ++e) r[e] = src(n1 + ln, k1 + lk + 8 * e); }
        u32x4 w;
        w.x = pk2(tile[(sk * 8 + 0) * 65 + sn], tile[(sk * 8 + 1) * 65 + sn]); w.y = pk2(tile[(sk * 8 + 2) * 65 + sn], tile[(sk * 8 + 3) * 65 + sn]);
        w.z = pk2(tile[(sk * 8 + 4) * 65 + sn], tile[(sk * 8 + 5) * 65 + sn]); w.w = pk2(tile[(sk * 8 + 6) * 65 + sn], tile[(sk * 8 + 7) * 65 + sn]);
        *(u32x4*)(Bt + (size_t)(n0 + sn) * K + k0 + sk * 8) = w;
    }
    __syncthreads();
}
__device__ __forceinline__ int win_map(int n) {
    if (n < 256) return n;
    if (n < 512) return 1456 + (n - 256);
    if (n < 768) return 1968 + (n - 512);
    if (n < 1024) return 1040 + (n - 768);
    if (n < 1152) return 1296 + (n - 1024);
    if (n < 1184) return 1424 + (n - 1152);
    if (n < 1440) return 256 + (n - 1184);
    if (n < 1696) return 512 + (n - 1440);
    if (n < 1952) return 768 + (n - 1696);
    if (n < 2080) return 1712 + (n - 1952);
    if (n < 2208) return 1840 + (n - 2080);
    if (n < 2720) return 2224 + (n - 2208);
    if (n < 2736) return 1024 + (n - 2720);
    if (n < 2744) return 2736 + (n - 2736);
    return -1;
}
__device__ __forceinline__ void conv_phase(const Ctx& c, int l) {
    unsigned char* wb = c.wb; int rot = 0;
    { const float* W = c.in(I_F1WI) + (size_t)l * 1024 * 5632;
      conv_job(c, (bf16_t*)(wb + WB_WI1), 1024, 5632, [=](int n, int k) { const int t = n >> 8, w = n & 255; const int col = w < 128 ? t * 128 + w : FF + t * 128 + (w - 128); return W[(size_t)k * 5632 + col]; }, rot); }
    { const float* W = c.in(I_F2WI) + (size_t)l * 1024 * 5632;
      conv_job(c, (bf16_t*)(wb + WB_WI2), 1024, 5632, [=](int n, int k) { const int t = n >> 8, w = n & 255; const int col = w < 128 ? t * 128 + w : FF + t * 128 + (w - 128); return W[(size_t)k * 5632 + col]; }, rot); }
    { const float* W = c.in(I_F1WO) + (size_t)l * 2816 * 1024;
      conv_job(c, (bf16_t*)(wb + WB_WO1), 2816, 1024, [=](int n, int k) { return W[(size_t)k * 1024 + n]; }, rot); }
    { const float* W = c.in(I_F2WO) + (size_t)l * 2816 * 1024;
      conv_job(c, (bf16_t*)(wb + WB_WO2), 2816, 1024, [=](int n, int k) { return W[(size_t)k * 1024 + n]; }, rot); }
    { const float* W = c.in(I_WIN) + (size_t)l * 1024 * 2744;
      conv_job(c, (bf16_t*)(wb + WB_WIN), 1024, 2816, [=](int n, int k) { const int col = win_map(n); return col >= 0 ? W[(size_t)k * 2744 + col] : 0.f; }, rot); }
    { const float* W = c.in(I_WOUT) + (size_t)l * 1024 * 1024;
      conv_job(c, (bf16_t*)(wb + WB_WOUT), 1024, 1024, [=](int n, int k) { const int ko = k < 256 ? k : (k < 512 ? k + 256 : (k < 768 ? k + 256 : k - 512)); return W[(size_t)ko * 1024 + n]; }, rot); }
    { const float* Wq = c.in(I_AWQ) + (size_t)l * 256 * 384; const float* Wkv = c.in(I_AWKV) + (size_t)l * 128 * 512;
      const float* qn = c.in(I_AQN) + l * 256; const float* kvn = c.in(I_AKVN) + l * 128;
      conv_job(c, (bf16_t*)(wb + WB_MLA), 384, 1024, [=](int n, int k) {
          if (n < 384) return k < 256 ? qn[k] * Wq[(size_t)k * 384 + n] : 0.f;
          if (n < 896) return k >= 256 ? kvn[k - 256] * Wkv[(size_t)(k - 256) * 512 + (n - 384)] : 0.f;
          return 0.f; }, rot); }
}

__device__ __forceinline__ void norm_phase(const Ctx& c, const float* srcl, const float* srcc, int nrows, const float* gain, const float* mod, int ish, int isc) {
    const int half = nrows >> 1;
    const int step = gridDim.x * 8;
    int row = blockIdx.x * 8 + c.wave;
    f32x4 v[2][4], vn[2][4];
    auto rowptr = [&](int r) { return r < RL ? srcl + (size_t)r * 1024 : srcc + (size_t)(r - RL) * 1024; };
    if (row < half) {
#pragma unroll
        for (int q = 0; q < 2; ++q) { const float* h = rowptr(row + q * half);
#pragma unroll
            for (int i = 0; i < 4; ++i) v[q][i] = *(const f32x4*)(h + i * 256 + c.lane * 4); }
    }
    for (; row < half; row += step) {
        const bool more = row + step < half;
        if (more) {
#pragma unroll
            for (int q = 0; q < 2; ++q) { const float* h = rowptr(row + step + q * half);
#pragma unroll
                for (int i = 0; i < 4; ++i) vn[q][i] = *(const f32x4*)(h + i * 256 + c.lane * 4); }
        }
        float ss[2];
#pragma unroll
        for (int q = 0; q < 2; ++q) { ss[q] = 0.f;
#pragma unroll
            for (int i = 0; i < 4; ++i) ss[q] += v[q][i][0] * v[q][i][0] + v[q][i][1] * v[q][i][1] + v[q][i][2] * v[q][i][2] + v[q][i][3] * v[q][i][3]; }
        ss[0] = wave_sum(ss[0]); ss[1] = wave_sum(ss[1]);
#pragma unroll
        for (int q = 0; q < 2; ++q) {
            const int r = row + q * half; const int bi = r < RL ? (r >> 11) : 16;
            const float* shp = mod + (size_t)(bi * 9 + ish) * 1024; const float* scp = mod + (size_t)(bi * 9 + isc) * 1024;
            const float rstd = __builtin_amdgcn_rsqf(ss[q] * (1.f / 1024.f) + EPS);
#pragma unroll
            for (int i = 0; i < 4; ++i) {
                const int col = i * 256 + c.lane * 4;
                const f32x4 g = *(const f32x4*)(gain + col), s4 = *(const f32x4*)(scp + col), h4 = *(const f32x4*)(shp + col);
                const f32x4 y = (v[q][i] * rstd * g) * (s4 + 1.f) + h4;
                u32x2 w; w.x = pk2(y[0], y[1]); w.y = pk2(y[2], y[3]);
                *(u32x2*)(c.xn + (size_t)r * 1024 + col) = w;
            }
        }
        if (more) {
#pragma unroll
            for (int q = 0; q < 2; ++q)
#pragma unroll
                for (int i = 0; i < 4; ++i) v[q][i] = vn[q][i];
        }
    }
}

#if N_MIX

__device__ __forceinline__ int chunk_row(int b, int tc) { return tc < 4 ? RL + b * CL + tc * 64 : b * TL + (tc - 4) * 64; }
__device__ __forceinline__ int scan_idx(int d, int tc) { return d == 0 ? tc : (tc < 4 ? 3 - tc : 39 - tc); }
__device__ __forceinline__ float wave_incl_scan(float v, int lane) {
#pragma unroll
    for (int o = 1; o < 64; o <<= 1) { const float t = __shfl_up(v, o); if (lane >= o) v += t; }
    return v;
}
__device__ __forceinline__ void ld8(const bf16_t* p, float (&o)[8]) {
    const u32x4 w = *(const u32x4*)p;
    o[0] = __uint_as_float(w.x << 16); o[1] = __uint_as_float(w.x & 0xffff0000u); o[2] = __uint_as_float(w.y << 16); o[3] = __uint_as_float(w.y & 0xffff0000u);
    o[4] = __uint_as_float(w.z << 16); o[5] = __uint_as_float(w.z & 0xffff0000u); o[6] = __uint_as_float(w.w << 16); o[7] = __uint_as_float(w.w & 0xffff0000u);
}
__device__ __forceinline__ void st8(bf16_t* p, const float (&v)[8]) {
    u32x4 w; w.x = pk2(v[0], v[1]); w.y = pk2(v[2], v[3]); w.z = pk2(v[4], v[5]); w.w = pk2(v[6], v[7]); *(u32x4*)p = w;
}

__device__ __forceinline__ void swa_prep(const Ctx& c, int l, int b, int tc) {
    bf16_t* vs = (bf16_t*)c.lds;
    const int rowbase = chunk_row(b, tc); const bool lat = tc >= 4;
    bf16_t* Ksw = (bf16_t*)(c.ws() + WS_KS); bf16_t* Vts = (bf16_t*)(c.ws() + WS_VTS);
    const float qg = c.in(I_SQG)[l * 64 + c.lane], kg = c.in(I_SKG)[l * 64 + c.lane];
    const int a = c.lane >> 5, pp = (c.lane >> 4) & 1, f = c.lane & 15;
    const float inv = __expf(-(float)f * (1.f / 16.f) * 9.210340372f);
    __syncthreads();
#pragma unroll 1
    for (int r = 0; r < 4; ++r) {
        int jj[2]; bf16_t* up[2]; bf16_t qraw[2][4], kraw[2][2], vraw[2][2];
#pragma unroll
        for (int q = 0; q < 2; ++q) {
            jj[q] = c.wave * 8 + r + q * 4; up[q] = c.U + (size_t)(rowbase + jj[q]) * UC;
#pragma unroll
            for (int h = 0; h < 4; ++h) qraw[q][h] = up[q][UC_WQ + h * 64 + c.lane];
#pragma unroll
            for (int kv = 0; kv < 2; ++kv) { kraw[q][kv] = up[q][UC_WK + kv * 64 + c.lane]; vraw[q][kv] = up[q][UC_WV + kv * 64 + c.lane]; }
        }
#pragma unroll
        for (int q = 0; q < 2; ++q) {
            const int j = jj[q];
            float cs = 1.f, sn = 0.f;
            if (lat) { const float ang = (float)(a ? j : (tc - 4)) * inv; sn = __sinf(ang); cs = __cosf(ang); }
            bf16_t qo[4], ko[2];
#pragma unroll
            for (int h = 0; h < 4; ++h) {
                const float x = bf2f(qraw[q][h]);
                const float ms = wave_sum(x * x) * (1.f / 64.f);
                float y = x * __builtin_amdgcn_rsqf(ms + EPS) * qg;
                const float pr = __shfl_xor(y, 16);
                y = pp == 0 ? y * cs - pr * sn : y * cs + pr * sn;
                qo[h] = f2bf(y);
            }
#pragma unroll
            for (int kv = 0; kv < 2; ++kv) {
                const float x = bf2f(kraw[q][kv]);
                const float ms = wave_sum(x * x) * (1.f / 64.f);
                float y = x * __builtin_amdgcn_rsqf(ms + EPS) * kg;
                const float pr = __shfl_xor(y, 16);
                y = pp == 0 ? y * cs - pr * sn : y * cs + pr * sn;
                ko[kv] = f2bf(y);
                vs[j * 128 + kv * 64 + c.lane] = vraw[q][kv];
            }
#pragma unroll
            for (int h = 0; h < 4; ++h) up[q][UC_WQ + h * 64 + c.lane] = qo[h];
#pragma unroll
            for (int kv = 0; kv < 2; ++kv) Ksw[((size_t)(b * 2 + kv) * KEYS + tc * 64 + j) * 64 + c.lane] = ko[kv];
        }
    }
    __syncthreads();
    { const int kd = c.tid >> 2, jq = c.tid & 3;
      bf16_t* dst = Vts + ((size_t)(b * 2 + (kd >> 6)) * 64 + (kd & 63)) * KEYS + tc * 64 + jq * 16;
      unsigned w[8];
#pragma unroll
      for (int i = 0; i < 8; ++i) w[i] = (unsigned)vs[(jq * 16 + 2 * i) * 128 + kd] | ((unsigned)vs[(jq * 16 + 2 * i + 1) * 128 + kd] << 16);
      *(u32x4*)dst = (u32x4){w[0], w[1], w[2], w[3]}; *(u32x4*)(dst + 8) = (u32x4){w[4], w[5], w[6], w[7]}; }
}

__device__ __forceinline__ void mm64(const bf16_t* A, const bf16_t* Bt, int wave, int fr, int fq, f32x4 (&acc)[2]) {
    const bf16_t* ap = A + ((wave >> 1) * 16 + fr) * 72 + fq * 8; const bf16_t* bp = Bt + ((wave & 1) * 32 + fr) * 72 + fq * 8;
#pragma unroll
    for (int kc = 0; kc < 2; ++kc) { const bf16x8 av = *(const bf16x8*)(ap + kc * 32);
#pragma unroll
        for (int ct = 0; ct < 2; ++ct) { const bf16x8 bv = *(const bf16x8*)(bp + ct * 16 * 72 + kc * 32); acc[ct] = __builtin_amdgcn_mfma_f32_16x16x32_bf16(av, bv, acc[ct], 0, 0, 0); } }
}

__device__ __forceinline__ void mlstm_local(const Ctx& c, int l, int b, int hh, int tc) {
    bf16_t* Vt = (bf16_t*)c.lds; bf16_t* Kf = Vt + 64 * 72; bf16_t* Kb = Kf + 64 * 72; float* wf = (float*)(Kb + 64 * 72); float* wb = wf + 64;
    const int rowbase = chunk_row(b, tc);
    bf16_t* STM = (bf16_t*)(c.ws() + WS_STM); float* DECM = (float*)(c.ws() + WS_DECM);
    const int fr = c.lane & 15, fq = c.lane >> 4, rt = (c.wave >> 1) * 16 + fq * 4, cb = (c.wave & 1) * 32 + fr;
    __syncthreads();
    float k8[8], v8[8];
    { const int j = c.tid >> 3, cg8 = c.tid & 7; const bf16_t* up = c.U + (size_t)(rowbase + j) * UC + hh * 64 + cg8 * 8; ld8(up + UC_MK, k8); ld8(up + UC_MV, v8); }
    if (c.wave == 0) {
        const float* gp = c.gates + (size_t)(rowbase + c.lane) * 32; const float* gb = c.in(I_MGB) + l * 16;
        const float i_f = gp[hh] + gb[hh], f_f = logsigf(gp[4 + hh] + gb[4 + hh]), i_b = gp[8 + hh] + gb[8 + hh], f_b = logsigf(gp[12 + hh] + gb[12 + hh]);
        const float cf = wave_incl_scan(f_f, c.lane), cbk = wave_incl_scan(f_b, c.lane);
        const float totf = __shfl(cf, 63), totb = __shfl(cbk, 63);
        wf[c.lane] = __expf(i_f + totf - cf) * 0.125f;
        wb[c.lane] = __expf(i_b + cbk - f_b) * 0.125f;
        if (c.lane == 0) { DECM[((b * 4 + hh) * 2 + 0) * NCH + scan_idx(0, tc)] = __expf(totf); DECM[((b * 4 + hh) * 2 + 1) * NCH + scan_idx(1, tc)] = __expf(totb); }
    }
    __syncthreads();
    { const int j = c.tid >> 3, cg8 = c.tid & 7; const float a = wf[j], bb = wb[j];
#pragma unroll
      for (int i = 0; i < 8; ++i) { Vt[(cg8 * 8 + i) * 72 + j] = f2bf(v8[i]); Kf[(cg8 * 8 + i) * 72 + j] = f2bf(k8[i] * a); Kb[(cg8 * 8 + i) * 72 + j] = f2bf(k8[i] * bb); } }
    __syncthreads();
    bf16_t* s0 = STM + ((size_t)((b * 4 + hh) * 2 + 0) * NCH + scan_idx(0, tc)) * 4160;
    bf16_t* s1 = STM + ((size_t)((b * 4 + hh) * 2 + 1) * NCH + scan_idx(1, tc)) * 4160;
    { f32x4 af[2], ab[2]; af[0] = (f32x4){0.f, 0.f, 0.f, 0.f}; af[1] = af[0]; ab[0] = af[0]; ab[1] = af[0];
      mm64(Vt, Kf, c.wave, fr, fq, af); mm64(Vt, Kb, c.wave, fr, fq, ab);
#pragma unroll
      for (int j = 0; j < 4; ++j) { s0[(rt + j) * 64 + cb] = f2bf(af[0][j]); s0[(rt + j) * 64 + cb + 16] = f2bf(af[1][j]); s1[(rt + j) * 64 + cb] = f2bf(ab[0][j]); s1[(rt + j) * 64 + cb + 16] = f2bf(ab[1][j]); } }
    { const int dk = c.tid >> 3, jg = c.tid & 7; float f8[8], b8[8]; ld8(Kf + dk * 72 + jg * 8, f8); ld8(Kb + dk * 72 + jg * 8, b8);
      float nf = 0.f, nb = 0.f;
#pragma unroll
      for (int i = 0; i < 8; ++i) { nf += f8[i]; nb += b8[i]; }
      nf += __shfl_xor(nf, 1); nf += __shfl_xor(nf, 2); nf += __shfl_xor(nf, 4); nb += __shfl_xor(nb, 1); nb += __shfl_xor(nb, 2); nb += __shfl_xor(nb, 4);
      if (jg == 0) { s0[4096 + dk] = f2bf(nf); s1[4096 + dk] = f2bf(nb); } }
}

__device__ __forceinline__ int ssd_gch(int grp, int lc) { return lc < 128 ? grp * 128 + lc : (lc < 192 ? 256 + grp * 64 + (lc - 128) : 384 + grp * 64 + (lc - 192)); }
template <bool WANT_C>
__device__ __forceinline__ void ssd_conv(const Ctx& c, int l, int b, int grp, int tc, bf16_t* xin, float* xc, float* Bd, int bstride_n, int bstride_s, float* Cc) {
    const int rowbase = chunk_row(b, tc); const int lcn = tc < 4 ? tc : tc - 4, nchk = tc < 4 ? 4 : 32;
    for (int idx = c.tid; idx < 68 * 32; idx += NTHR) {
        const int rr = idx >> 5, ch8 = idx & 31, lc = ch8 * 8;
        const int trel = rr - 2; const bool ok = !((lcn == 0 && trel < 0) || (lcn == nchk - 1 && trel >= 64));
        u32x4 w = (u32x4){0u, 0u, 0u, 0u};
        if (ok) w = *(const u32x4*)(c.U + (size_t)(rowbase + trel) * UC + UC_XBC + ssd_gch(grp, lc));
        *(u32x4*)(xin + rr * 256 + lc) = w;
    }
    __syncthreads();
    { const int lc = c.tid & 255, jh = c.tid >> 8, gch = ssd_gch(grp, lc);
      const float* cw = c.in(I_CW) + (size_t)l * 5 * 512 + gch; const float w0 = cw[0], w1 = cw[512], w2 = cw[1024], w3 = cw[1536], w4 = cw[2048], bias = c.in(I_CB)[l * 512 + gch];
      if (WANT_C || lc < 192) {
#pragma unroll 2
        for (int j = jh * 32; j < jh * 32 + 32; ++j) {
            const float y = bias + w0 * bf2f(xin[j * 256 + lc]) + w1 * bf2f(xin[(j + 1) * 256 + lc]) + w2 * bf2f(xin[(j + 2) * 256 + lc]) + w3 * bf2f(xin[(j + 3) * 256 + lc]) + w4 * bf2f(xin[(j + 4) * 256 + lc]);
            const float v = siluf(y);
            if (lc < 128) xc[j * 128 + lc] = v; else if (lc < 192) Bd[(lc - 128) * bstride_n + j * bstride_s] = v; else if (WANT_C) Cc[j * 65 + (lc - 192)] = v;
        }
      } }
}
__device__ __forceinline__ void ssd_gate(const Ctx& c, int l, int row, int h, int d, float& a, float& dt, float& pf, float& tot) {
    dt = softplusf(c.gates[(size_t)row * 32 + 16 + d * 4 + h] + c.in(I_DTB)[l * 8 + d * 4 + h]);
    a = -__expf(c.in(I_ALOG)[l * 8 + d * 4 + h]) * dt;
    pf = wave_incl_scan(a, c.lane); tot = __shfl(pf, 63);
}
__device__ __forceinline__ void ssd_local(const Ctx& c, int l, int b, int grp, int tc) {
    bf16_t* xin = (bf16_t*)c.lds; bf16_t* Xt = (bf16_t*)(c.lds + 68 * 256 * 2); bf16_t* Bw = Xt + 128 * 72; float* wd = (float*)(Bw + 4 * 64 * 72);
    bf16_t* STS = (bf16_t*)(c.ws() + WS_STS); float* DECS = (float*)(c.ws() + WS_DECS);
    const int rowbase = chunk_row(b, tc); const int lcn = tc < 4 ? tc : tc - 4, nchk = tc < 4 ? 4 : 32;
    const int fr = c.lane & 15, fq = c.lane >> 4, rt = (c.wave >> 1) * 16 + fq * 4, cb = (c.wave & 1) * 32 + fr;
    __syncthreads();
    for (int idx = c.tid; idx < 68 * 24; idx += NTHR) {
        const int rr = idx / 24, lc = (idx % 24) * 8, trel = rr - 2; const bool ok = !((lcn == 0 && trel < 0) || (lcn == nchk - 1 && trel >= 64));
        u32x4 w = (u32x4){0u, 0u, 0u, 0u};
        if (ok) w = *(const u32x4*)(c.U + (size_t)(rowbase + trel) * UC + UC_XBC + ssd_gch(grp, lc));
        *(u32x4*)(xin + rr * 256 + lc) = w;
    }
    if (c.wave < 4) {
        const int hl = c.wave >> 1, d = c.wave & 1, h = grp * 2 + hl; float a, dt, pf, tot;
        ssd_gate(c, l, rowbase + c.lane, h, d, a, dt, pf, tot);
        wd[c.wave * 64 + c.lane] = (d == 0 ? __expf(tot - pf) : __expf(pf - a)) * dt;
        if (c.lane == 0) DECS[((b * 4 + h) * 2 + d) * NCH + scan_idx(d, tc)] = __expf(tot);
    }
    __syncthreads();
    if (c.tid < 384) { const int lc = c.tid % 192, jh = c.tid / 192, gch = ssd_gch(grp, lc);
      const float* cw = c.in(I_CW) + (size_t)l * 5 * 512 + gch; const float w0 = cw[0], w1 = cw[512], w2 = cw[1024], w3 = cw[1536], w4 = cw[2048], bias = c.in(I_CB)[l * 512 + gch];
#pragma unroll 2
      for (int j = jh * 32; j < jh * 32 + 32; ++j) {
          const float y = bias + w0 * bf2f(xin[j * 256 + lc]) + w1 * bf2f(xin[(j + 1) * 256 + lc]) + w2 * bf2f(xin[(j + 2) * 256 + lc]) + w3 * bf2f(xin[(j + 3) * 256 + lc]) + w4 * bf2f(xin[(j + 4) * 256 + lc]);
          const float v = siluf(y);
          if (lc < 128) Xt[lc * 72 + j] = f2bf(v);
          else {
#pragma unroll
              for (int q = 0; q < 4; ++q) Bw[(q * 64 + (lc - 128)) * 72 + j] = f2bf(v * wd[q * 64 + j]); }
      } }
    __syncthreads();
#pragma unroll 1
    for (int q = 0; q < 4; ++q) {
        f32x4 sa[2]; sa[0] = (f32x4){0.f, 0.f, 0.f, 0.f}; sa[1] = sa[0];
        mm64(Xt + (q >> 1) * 64 * 72, Bw + q * 64 * 72, c.wave, fr, fq, sa);
        bf16_t* sp = STS + ((size_t)((b * 4 + grp * 2 + (q >> 1)) * 2 + (q & 1)) * NCH + scan_idx(q & 1, tc)) * 4096;
#pragma unroll
        for (int j = 0; j < 4; ++j) { sp[(rt + j) * 64 + cb] = f2bf(sa[0][j]); sp[(rt + j) * 64 + cb + 16] = f2bf(sa[1][j]); }
    }
}

__device__ __forceinline__ void scan_vec8(bf16_t* base, int per_elems, const float* dec) {
    float cs[8];
#pragma unroll
    for (int i = 0; i < 8; ++i) cs[i] = 0.f;
#pragma unroll 1
    for (int k0 = 0; k0 < NCH; k0 += 9) {
        u32x4 w[9]; float dk[9];
#pragma unroll
        for (int k = 0; k < 9; ++k) { w[k] = *(const u32x4*)(base + (size_t)(k0 + k) * per_elems); dk[k] = dec[k0 + k]; }
#pragma unroll
        for (int k = 0; k < 9; ++k) {
            st8(base + (size_t)(k0 + k) * per_elems, cs);
            const float u8[8] = {__uint_as_float(w[k].x << 16), __uint_as_float(w[k].x & 0xffff0000u), __uint_as_float(w[k].y << 16), __uint_as_float(w[k].y & 0xffff0000u),
                                 __uint_as_float(w[k].z << 16), __uint_as_float(w[k].z & 0xffff0000u), __uint_as_float(w[k].w << 16), __uint_as_float(w[k].w & 0xffff0000u)};
#pragma unroll
            for (int i = 0; i < 8; ++i) cs[i] = dk[k] * cs[i] + u8[i];
        }
    }
}
__device__ __forceinline__ void scan_phase(const Ctx& c) {
    bf16_t* STM = (bf16_t*)(c.ws() + WS_STM); bf16_t* STS = (bf16_t*)(c.ws() + WS_STS); const float* DM = (const float*)(c.ws() + WS_DECM); const float* DS = (const float*)(c.ws() + WS_DECS);
    constexpr int NV = 128 * 512;
    for (int it = blockIdx.x * NTHR + c.tid; it < 2 * NV; it += gridDim.x * NTHR) {
        const bool isM = it < NV; const int u = isM ? it : it - NV, chain = u >> 9, v = u & 511;
        if (isM) scan_vec8(STM + (size_t)chain * NCH * 4160 + v * 8, 4160, DM + chain * NCH);
        else scan_vec8(STS + (size_t)chain * NCH * 4096 + v * 8, 4096, DS + chain * NCH);
    }
    for (int it = ((int)gridDim.x - 1 - (int)blockIdx.x) * NTHR + c.tid; it < 128 * 8; it += gridDim.x * NTHR) {
        const int chain = it >> 3, v = it & 7;
        scan_vec8(STM + (size_t)chain * NCH * 4160 + 4096 + v * 8, 4160, DM + chain * NCH);
    }
}

__device__ __forceinline__ void mla_finish(const Ctx& c, int l, int b, int tc) {
    bf16_t* vs = (bf16_t*)c.lds;
    const int rowbase = chunk_row(b, tc); const bool lat = tc >= 4;
    bf16_t* QM = (bf16_t*)(c.ws() + WS_QM); bf16_t* KM = (bf16_t*)(c.ws() + WS_KM); bf16_t* VTM = (bf16_t*)(c.ws() + WS_VTM);
    const bf16_t* QKV = c.xn;
    const float qgn = c.in(I_AQG)[l * 96 + c.lane], kgn = c.in(I_AKG)[l * 96 + c.lane];
    const float qgr = c.lane < 32 ? c.in(I_AQG)[l * 96 + 64 + c.lane] : 0.f, kgr = c.lane < 32 ? c.in(I_AKG)[l * 96 + 64 + c.lane] : 0.f;
    const int a = (c.lane >> 4) & 1, pp = (c.lane >> 3) & 1, f = c.lane & 7;
    const float inv = __expf(-(float)f * (1.f / 8.f) * 9.210340372f);
    __syncthreads();
#pragma unroll 1
    for (int r = 0; r < 4; ++r) {
        int jj[2], pos[2]; const bf16_t* up[2]; const bf16_t* rp[2];
        u32x2 waq[2]; unsigned wakv[2]; bf16_t krr[2], rqn[2][4], rqr[2][4], rkn[2][4], rvv[2][4];
#pragma unroll
        for (int q = 0; q < 2; ++q) {
            jj[q] = c.wave * 8 + r + q * 4; const int row = rowbase + jj[q]; pos[q] = tc * 64 + jj[q];
            up[q] = c.U + (size_t)row * UC; rp[q] = QKV + (size_t)row * 1024;
            waq[q] = *(const u32x2*)(up[q] + UC_AQ + c.lane * 4); wakv[q] = *(const unsigned*)(up[q] + UC_AKV + c.lane * 2);
            krr[q] = c.lane < 32 ? up[q][UC_AKR + c.lane] : (bf16_t)0;
#pragma unroll
            for (int h = 0; h < 4; ++h) { rqn[q][h] = rp[q][h * 96 + c.lane]; rqr[q][h] = c.lane < 32 ? rp[q][h * 96 + 64 + c.lane] : (bf16_t)0; rkn[q][h] = rp[q][384 + h * 128 + c.lane]; rvv[q][h] = rp[q][384 + h * 128 + 64 + c.lane]; }
        }
#pragma unroll
        for (int q = 0; q < 2; ++q) {
            const int j = jj[q];
            float cs = 1.f, sn = 0.f;
            if (lat) { const float ang = (float)(a ? j : (tc - 4)) * inv; sn = __sinf(ang); cs = __cosf(ang); }
            float ss;
            { const float x0 = __uint_as_float(waq[q].x << 16), x1 = __uint_as_float(waq[q].x & 0xffff0000u), x2 = __uint_as_float(waq[q].y << 16), x3 = __uint_as_float(waq[q].y & 0xffff0000u);
              ss = wave_sum(x0 * x0 + x1 * x1 + x2 * x2 + x3 * x3); }
            const float rq = __builtin_amdgcn_rsqf(ss * (1.f / 256.f) + EPS);
            { const float x0 = __uint_as_float(wakv[q] << 16), x1 = __uint_as_float(wakv[q] & 0xffff0000u); ss = wave_sum(x0 * x0 + x1 * x1); }
            const float rkv = __builtin_amdgcn_rsqf(ss * (1.f / 128.f) + EPS);
            bf16_t oqn[4], oqr[4], okn[4];
#pragma unroll
            for (int h = 0; h < 4; ++h) {
                { const float x = bf2f(rqn[q][h]) * rq; const float ms = wave_sum(x * x) * (1.f / 64.f); oqn[h] = f2bf(x * __builtin_amdgcn_rsqf(ms + EPS) * qgn); }
                { const float x = bf2f(rqr[q][h]) * rq; const float ms = wave_sum(x * x) * (1.f / 32.f);
                  float y = x * __builtin_amdgcn_rsqf(ms + EPS) * qgr; const float pr = __shfl_xor(y, 8); y = pp == 0 ? y * cs - pr * sn : y * cs + pr * sn; oqr[h] = f2bf(y); }
                { const float x = bf2f(rkn[q][h]) * rkv; const float ms = wave_sum(x * x) * (1.f / 64.f); okn[h] = f2bf(x * __builtin_amdgcn_rsqf(ms + EPS) * kgn); }
                vs[j * 256 + h * 64 + c.lane] = f2bf(bf2f(rvv[q][h]) * rkv);
            }
            bf16_t okr;
            { const float x = bf2f(krr[q]); const float ms = wave_sum(x * x) * (1.f / 32.f);
              float y = x * __builtin_amdgcn_rsqf(ms + EPS) * kgr; const float pr = __shfl_xor(y, 8); y = pp == 0 ? y * cs - pr * sn : y * cs + pr * sn; okr = f2bf(y); }
#pragma unroll
            for (int h = 0; h < 4; ++h) {
                const size_t qo = ((size_t)(b * 4 + h) * KEYS + pos[q]) * 96;
                QM[qo + c.lane] = oqn[h]; KM[qo + c.lane] = okn[h];
                if (c.lane < 32) { QM[qo + 64 + c.lane] = oqr[h]; KM[qo + 64 + c.lane] = okr; }
            }
        }
    }
    __syncthreads();
    { const int hd = c.tid >> 1, jh = c.tid & 1;
      bf16_t* dst = VTM + ((size_t)(b * 4 + (hd >> 6)) * 64 + (hd & 63)) * KEYS + tc * 64 + jh * 32;
#pragma unroll
      for (int q = 0; q < 4; ++q) { unsigned w[4];
#pragma unroll
          for (int i = 0; i < 4; ++i) w[i] = (unsigned)vs[(jh * 32 + q * 8 + 2 * i) * 256 + hd] | ((unsigned)vs[(jh * 32 + q * 8 + 2 * i + 1) * 256 + hd] << 16);
          *(u32x4*)(dst + q * 8) = (u32x4){w[0], w[1], w[2], w[3]}; } }
}

typedef short bf16x4 __attribute__((ext_vector_type(4)));
template <int DQ>
__device__ __forceinline__ void attn_task(const Ctx& c, const bf16_t* Qp, int qstride, const bf16_t* Kb, const bf16_t* Vtb, int nloc, int loc0, bool masked, int tq0,
                                          float scale, float sink, bool has_sink, bf16_t* Op, int ostride) {
    constexpr int KS = DQ + 8, KCH = DQ / 8;
    constexpr float L2E = 1.44269504089f;
    bf16_t* Ks = (bf16_t*)c.lds; bf16_t* Vs = Ks + 2 * 64 * KS;
    const int fr = c.lane & 15, fq = c.lane >> 4;
    const float sc2 = scale * L2E;
    bf16x8 qa[2][DQ / 32];
#pragma unroll
    for (int g = 0; g < 2; ++g) { const bf16_t* qrow = Qp + (size_t)(c.wave * 32 + g * 16 + fr) * qstride;
#pragma unroll
      for (int kc = 0; kc < DQ / 32; ++kc) qa[g][kc] = *(const bf16x8*)(qrow + kc * 32 + fq * 8); }
    f32x4 o[2][4]; float m[2], ls[2];
#pragma unroll
    for (int g = 0; g < 2; ++g) { m[g] = has_sink ? sink * L2E : -1e30f; ls[g] = (has_sink && fq == 0) ? 1.f : 0.f;
#pragma unroll
        for (int i = 0; i < 4; ++i) o[g][i] = (f32x4){0.f, 0.f, 0.f, 0.f}; }
    const int ntiles = 4 + nloc;
    const int kr0 = c.tid / KCH, kc0 = c.tid % KCH, kr1 = (c.tid + NTHR) / KCH, kc1 = (c.tid + NTHR) % KCH; const bool k2 = (DQ == 96) && (c.tid < 64 * KCH - NTHR);
    const int vr = c.tid >> 3, vc = c.tid & 7;
    u32x4 rk0, rk1 = (u32x4){0u, 0u, 0u, 0u}, rv;
    { const int tile = 0;
      rk0 = *(const u32x4*)(Kb + (size_t)(tile * 64 + kr0) * DQ + kc0 * 8); if (k2) rk1 = *(const u32x4*)(Kb + (size_t)(tile * 64 + kr1) * DQ + kc1 * 8);
      rv = *(const u32x4*)(Vtb + (size_t)vr * KEYS + tile * 64 + vc * 8); }
    __syncthreads();
#pragma unroll 1
    for (int it = 0; it < ntiles; ++it) {
        const int tile = it < 4 ? it : loc0 + (it - 4);
        bf16_t* Kc = Ks + (it & 1) * 64 * KS; bf16_t* Vc = Vs + (it & 1) * 64 * 72;
        *(u32x4*)(Kc + kr0 * KS + kc0 * 8) = rk0; if (k2) *(u32x4*)(Kc + kr1 * KS + kc1 * 8) = rk1;
        *(u32x4*)(Vc + vr * 72 + vc * 8) = rv;
        __syncthreads();
        if (it + 1 < ntiles) { const int tn = (it + 1) < 4 ? (it + 1) : loc0 + (it + 1 - 4);
            rk0 = *(const u32x4*)(Kb + (size_t)(tn * 64 + kr0) * DQ + kc0 * 8); if (k2) rk1 = *(const u32x4*)(Kb + (size_t)(tn * 64 + kr1) * DQ + kc1 * 8);
            rv = *(const u32x4*)(Vtb + (size_t)vr * KEYS + tn * 64 + vc * 8); }
        f32x4 s[2][4];
#pragma unroll
        for (int nt = 0; nt < 4; ++nt) { s[0][nt] = (f32x4){0.f, 0.f, 0.f, 0.f}; s[1][nt] = s[0][nt];
#pragma unroll
            for (int kc = 0; kc < DQ / 32; ++kc) { const bf16x8 kb = *(const bf16x8*)(Kc + (nt * 16 + fr) * KS + kc * 32 + fq * 8);
                s[0][nt] = __builtin_amdgcn_mfma_f32_16x16x32_bf16(kb, qa[0][kc], s[0][nt], 0, 0, 0); s[1][nt] = __builtin_amdgcn_mfma_f32_16x16x32_bf16(kb, qa[1][kc], s[1][nt], 0, 0, 0); } }
        const bool mk = masked && it >= 4;
        bf16x8 pb[2][2];
#pragma unroll
        for (int g = 0; g < 2; ++g) {
            float mx = -1e30f;
            const int tq = tq0 + c.wave * 32 + g * 16 + fr;
#pragma unroll
            for (int nt = 0; nt < 4; ++nt)
#pragma unroll
                for (int j = 0; j < 4; ++j) { float v = s[g][nt][j] * sc2;
                    if (mk) { const int dd = tq - ((tile - 4) * 64 + nt * 16 + fq * 4 + j); if (dd > 128 || dd < -128) v = -1e30f; }
                    s[g][nt][j] = v; mx = fmaxf(mx, v); }
            mx = fmaxf(mx, __shfl_xor(mx, 16)); mx = fmaxf(mx, __shfl_xor(mx, 32));
            const float mn = fmaxf(m[g], mx), al = __builtin_amdgcn_exp2f(m[g] - mn); m[g] = mn;
            float rs = 0.f;
#pragma unroll
            for (int nt = 0; nt < 4; ++nt)
#pragma unroll
                for (int j = 0; j < 4; ++j) { const float pv = __builtin_amdgcn_exp2f(s[g][nt][j] - mn); s[g][nt][j] = pv; rs += pv; }
            ls[g] = ls[g] * al + rs;
#pragma unroll
            for (int dv = 0; dv < 4; ++dv) o[g][dv] *= al;
#pragma unroll
            for (int kc = 0; kc < 2; ++kc) { u32x4 w; w.x = pk2(s[g][2 * kc][0], s[g][2 * kc][1]); w.y = pk2(s[g][2 * kc][2], s[g][2 * kc][3]);
                w.z = pk2(s[g][2 * kc + 1][0], s[g][2 * kc + 1][1]); w.w = pk2(s[g][2 * kc + 1][2], s[g][2 * kc + 1][3]); pb[g][kc] = __builtin_bit_cast(bf16x8, w); }
        }
#pragma unroll
        for (int kc = 0; kc < 2; ++kc)
#pragma unroll
            for (int dv = 0; dv < 4; ++dv) {
                const bf16_t* vp = Vc + (dv * 16 + fr) * 72 + kc * 32 + fq * 4;
                const bf16x4 v0 = *(const bf16x4*)vp, v1 = *(const bf16x4*)(vp + 16);
                const bf16x8 va = __builtin_shufflevector(v0, v1, 0, 1, 2, 3, 4, 5, 6, 7);
                o[0][dv] = __builtin_amdgcn_mfma_f32_16x16x32_bf16(va, pb[0][kc], o[0][dv], 0, 0, 0); o[1][dv] = __builtin_amdgcn_mfma_f32_16x16x32_bf16(va, pb[1][kc], o[1][dv], 0, 0, 0); }
    }
#pragma unroll
    for (int g = 0; g < 2; ++g) {
        float lt = ls[g]; lt += __shfl_xor(lt, 16); lt += __shfl_xor(lt, 32);
        const float il = __builtin_amdgcn_rcpf(lt);
        bf16_t* orow = Op + (size_t)(c.wave * 32 + g * 16 + fr) * ostride + fq * 4;
#pragma unroll
        for (int dv = 0; dv < 4; ++dv) { u32x2 w; w.x = pk2(o[g][dv][0] * il, o[g][dv][1] * il); w.y = pk2(o[g][dv][2] * il, o[g][dv][3] * il); *(u32x2*)(orow + dv * 16) = w; }
    }
}

__device__ __forceinline__ void mlstm_out(const Ctx& c, int l, int b, int hh, int tc) {
    bf16_t* Qs = (bf16_t*)c.lds; bf16_t* Kn = Qs + 64 * 72; bf16_t* Vt = Kn + 64 * 72; bf16_t* Ct = Vt + 64 * 72; bf16_t* Ss = Ct + 64 * 72;
    float* hbuf = (float*)(Ss + 64 * 72); float* nv = hbuf + 64 * 65; float* bcum = nv + 64; float* ig = bcum + 64; float* qn = ig + 64; float* denp = qn + 64;
    const int rowbase = chunk_row(b, tc);
    const bf16_t* STM = (const bf16_t*)(c.ws() + WS_STM);
    const int t = c.tid >> 3, eg = c.tid & 7, fr = c.lane & 15, fq = c.lane >> 4;
    const int rt = (c.wave >> 1) * 16 + fq * 4, cb = (c.wave & 1) * 32 + fr;
    __syncthreads();
    { const bf16_t* up = c.U + (size_t)(rowbase + t) * UC + hh * 64 + eg * 8; float k8[8], v8[8];
      *(u32x4*)(Qs + t * 72 + eg * 8) = *(const u32x4*)(up + UC_MQ); ld8(up + UC_MK, k8); ld8(up + UC_MV, v8);
#pragma unroll
      for (int i = 0; i < 8; ++i) { k8[i] *= 0.125f; Vt[(eg * 8 + i) * 72 + t] = f2bf(v8[i]); }
      st8(Kn + t * 72 + eg * 8, k8); }
    f32x4 hacc[2];
    hacc[0] = (f32x4){0.f, 0.f, 0.f, 0.f}; hacc[1] = hacc[0];
    u32x4 stw[2]; bf16_t nvw[2]; float gbc[2] = {0.f, 0.f}, giv[2] = {0.f, 0.f};
#pragma unroll
    for (int d = 0; d < 2; ++d) { const bf16_t* st = STM + ((size_t)((b * 4 + hh) * 2 + d) * NCH + scan_idx(d, tc)) * 4160;
        stw[d] = *(const u32x4*)(st + t * 64 + eg * 8); nvw[d] = c.tid < 64 ? st[4096 + c.tid] : (bf16_t)0; }
    if (c.wave == 0) {
        const float* gp = c.gates + (size_t)(rowbase + c.lane) * 32; const float* gb = c.in(I_MGB) + l * 16;
#pragma unroll
        for (int d = 0; d < 2; ++d) {
            const float iv = gp[d * 8 + hh] + gb[d * 8 + hh], fv = logsigf(gp[d * 8 + 4 + hh] + gb[d * 8 + 4 + hh]);
            const float pf = wave_incl_scan(fv, c.lane), tot = __shfl(pf, 63);
            gbc[d] = d == 0 ? pf : (tot - pf + fv); giv[d] = iv; }
    }
#pragma unroll
    for (int d = 0; d < 2; ++d) {
        __syncthreads();
        if (c.wave == 0) { bcum[c.lane] = gbc[d]; ig[c.lane] = giv[d]; }
        *(u32x4*)(Ct + t * 72 + eg * 8) = stw[d];
        if (c.tid < 64) nv[c.tid] = bf2f(nvw[d]);
        __syncthreads();
        { float q8[8]; ld8(Qs + t * 72 + eg * 8, q8); float part = 0.f;
#pragma unroll
          for (int i = 0; i < 8; ++i) part += q8[i] * nv[eg * 8 + i];
          part += __shfl_xor(part, 1); part += __shfl_xor(part, 2); part += __shfl_xor(part, 4);
          if (eg == 0) qn[t] = part; }
        { f32x4 sa[2]; sa[0] = (f32x4){0.f, 0.f, 0.f, 0.f}; sa[1] = sa[0];
          mm64(Qs, Kn, c.wave, fr, fq, sa);
#pragma unroll
          for (int j = 0; j < 4; ++j) { const int tt = rt + j; const float bt = bcum[tt]; float rs = 0.f;
#pragma unroll
              for (int ct = 0; ct < 2; ++ct) { const int ss = cb + ct * 16; const bool ok = d == 0 ? (ss <= tt) : (ss >= tt);
                  const float v = ok ? sa[ct][j] * __expf(bt - bcum[ss] + ig[ss]) : 0.f; Ss[tt * 72 + ss] = f2bf(v); rs += v; }
              rs = row16_sum(rs);
              if (fr == 0) denp[tt * 2 + (c.wave & 1)] = rs; } }
        __syncthreads();
        { f32x4 na[2]; na[0] = (f32x4){0.f, 0.f, 0.f, 0.f}; na[1] = na[0];
          mm64(Qs, Ct, c.wave, fr, fq, na);
#pragma unroll
          for (int j = 0; j < 4; ++j) { const float ebt = __expf(bcum[rt + j]); na[0][j] *= ebt; na[1][j] *= ebt; }
          mm64(Ss, Vt, c.wave, fr, fq, na);
#pragma unroll
          for (int j = 0; j < 4; ++j) { const int tt = rt + j; const float den = denp[tt * 2] + denp[tt * 2 + 1] + __expf(bcum[tt]) * qn[tt];
              const float idn = __builtin_amdgcn_rcpf(fmaxf(fabsf(den), 1.f)); hacc[0][j] += na[0][j] * idn; hacc[1][j] += na[1][j] * idn; } }
    }
#pragma unroll
    for (int j = 0; j < 4; ++j) { hbuf[(rt + j) * 65 + cb] = hacc[0][j]; hbuf[(rt + j) * 65 + cb + 16] = hacc[1][j]; }
    __syncthreads();
    float h8[8]; float ss = 0.f;
#pragma unroll
    for (int i = 0; i < 8; ++i) { h8[i] = hbuf[t * 65 + eg * 8 + i]; ss += h8[i] * h8[i]; }
    ss += __shfl_xor(ss, 1); ss += __shfl_xor(ss, 2); ss += __shfl_xor(ss, 4);
    const float rs = __builtin_amdgcn_rsqf(ss * (1.f / 64.f) + EPS);
    bf16_t* up = c.U + (size_t)(rowbase + t) * UC + hh * 64 + eg * 8; float mo[8], o8[8]; ld8(up + UC_MO, mo);
    const float* on = c.in(I_MON) + l * 256 + hh * 64 + eg * 8;
#pragma unroll
    for (int i = 0; i < 8; ++i) o8[i] = sigmf(mo[i]) * (h8[i] * rs * on[i]);
    st8(up + UC_MQ, o8);
}

__device__ __forceinline__ void ssd_out(const Ctx& c, int l, int b, int grp, int tc) {
    bf16_t* xin = (bf16_t*)c.lds;
    float* ybuf = (float*)c.lds;
    bf16_t* Xt = (bf16_t*)(c.lds + 68 * 256 * 2);
    bf16_t* Bn = Xt + 128 * 72; bf16_t* Cn = Bn + 64 * 72; bf16_t* Ws = Cn + 64 * 72; bf16_t* Sp = Ws + 64 * 72;
    float* Gs = (float*)(Sp + 64 * 72);
    float* cum = Gs + 64 * 65; float* dtv = cum + 256;
    const bf16_t* STS = (const bf16_t*)(c.ws() + WS_STS);
    const int rowbase = chunk_row(b, tc); const int lcn = tc < 4 ? tc : tc - 4, nchk = tc < 4 ? 4 : 32;
    const int t = c.tid >> 3, pg = c.tid & 7, fr = c.lane & 15, fq = c.lane >> 4;
    const int rt = (c.wave >> 1) * 16 + fq * 4, cb = (c.wave & 1) * 32 + fr;
    __syncthreads();
    for (int idx = c.tid; idx < 68 * 32; idx += NTHR) {
        const int rr = idx >> 5, lc = (idx & 31) * 8, trel = rr - 2; const bool ok = !((lcn == 0 && trel < 0) || (lcn == nchk - 1 && trel >= 64));
        u32x4 w = (u32x4){0u, 0u, 0u, 0u};
        if (ok) w = *(const u32x4*)(c.U + (size_t)(rowbase + trel) * UC + UC_XBC + ssd_gch(grp, lc));
        *(u32x4*)(xin + rr * 256 + lc) = w;
    }
    if (c.wave < 4) {
        const int hl = c.wave >> 1, d = c.wave & 1, h = grp * 2 + hl; float a, dt, pf, tot;
        ssd_gate(c, l, rowbase + c.lane, h, d, a, dt, pf, tot);
        cum[c.wave * 64 + c.lane] = d == 0 ? pf : (tot - pf + a); dtv[c.wave * 64 + c.lane] = dt;
    }
    __syncthreads();
    { const int lc = c.tid & 255, jh = c.tid >> 8, gch = ssd_gch(grp, lc);
      const float* cw = c.in(I_CW) + (size_t)l * 5 * 512 + gch; const float w0 = cw[0], w1 = cw[512], w2 = cw[1024], w3 = cw[1536], w4 = cw[2048], bias = c.in(I_CB)[l * 512 + gch];
#pragma unroll 2
      for (int j = jh * 32; j < jh * 32 + 32; ++j) {
          const float y = bias + w0 * bf2f(xin[j * 256 + lc]) + w1 * bf2f(xin[(j + 1) * 256 + lc]) + w2 * bf2f(xin[(j + 2) * 256 + lc]) + w3 * bf2f(xin[(j + 3) * 256 + lc]) + w4 * bf2f(xin[(j + 4) * 256 + lc]);
          const bf16_t v = f2bf(siluf(y));
          if (lc < 128) Xt[lc * 72 + j] = v; else if (lc < 192) Bn[j * 72 + (lc - 128)] = v; else Cn[j * 72 + (lc - 192)] = v;
      } }
    __syncthreads();
    { f32x4 g[2]; g[0] = (f32x4){0.f, 0.f, 0.f, 0.f}; g[1] = g[0];
      mm64(Cn, Bn, c.wave, fr, fq, g);
#pragma unroll
      for (int j = 0; j < 4; ++j) { Gs[(rt + j) * 65 + cb] = g[0][j]; Gs[(rt + j) * 65 + cb + 16] = g[1][j]; } }
    f32x4 yacc[2][2];
#pragma unroll
    for (int q = 0; q < 2; ++q) { yacc[q][0] = (f32x4){0.f, 0.f, 0.f, 0.f}; yacc[q][1] = yacc[q][0]; }
    u32x4 stn = *(const u32x4*)(STS + ((size_t)((b * 4 + grp * 2) * 2) * NCH + scan_idx(0, tc)) * 4096 + t * 64 + pg * 8);
#pragma unroll 1
    for (int hd = 0; hd < 4; ++hd) {
        { const int hl = hd >> 1, d = hd & 1;
            __syncthreads();
            const float* cm = cum + (hl * 2 + d) * 64; const float* dv = dtv + (hl * 2 + d) * 64;
            { *(u32x4*)(Sp + t * 72 + pg * 8) = stn;
              if (hd < 3) { const int h2 = (hd + 1) >> 1, d2 = (hd + 1) & 1; stn = *(const u32x4*)(STS + ((size_t)((b * 4 + grp * 2 + h2) * 2 + d2) * NCH + scan_idx(d2, tc)) * 4096 + t * 64 + pg * 8); }
              const float ct = cm[t]; float w8[8];
#pragma unroll
              for (int i = 0; i < 8; ++i) { const int ss = pg * 8 + i; const bool ok = d == 0 ? (ss <= t) : (ss >= t);
                  w8[i] = ok ? Gs[t * 65 + ss] * __expf(ct - cm[ss]) * dv[ss] : 0.f; }
              st8(Ws + t * 72 + pg * 8, w8); }
            __syncthreads();
            f32x4 ya[2]; ya[0] = (f32x4){0.f, 0.f, 0.f, 0.f}; ya[1] = ya[0];
            mm64(Cn, Sp, c.wave, fr, fq, ya);
#pragma unroll
            for (int j = 0; j < 4; ++j) { const float ect = __expf(cm[rt + j]); ya[0][j] *= ect; ya[1][j] *= ect; }
            mm64(Ws, Xt + hl * 64 * 72, c.wave, fr, fq, ya);
            if (hl == 0) { yacc[0][0] += ya[0]; yacc[0][1] += ya[1]; } else { yacc[1][0] += ya[0]; yacc[1][1] += ya[1]; }
        }
    }
#pragma unroll
    for (int hl = 0; hl < 2; ++hl)
#pragma unroll
        for (int j = 0; j < 4; ++j) { ybuf[(rt + j) * 129 + hl * 64 + cb] = yacc[hl][0][j]; ybuf[(rt + j) * 129 + hl * 64 + cb + 16] = yacc[hl][1][j]; }
    __syncthreads();
    float ss = 0.f; float g[2][8];
#pragma unroll
    for (int hl = 0; hl < 2; ++hl) {
        const int h = grp * 2 + hl; const float dsk = c.in(I_SD)[l * 4 + h];
        float z8[8]; ld8(c.U + (size_t)(rowbase + t) * UC + UC_SZ + h * 64 + pg * 8, z8);
#pragma unroll
        for (int i = 0; i < 8; ++i) { const float yy = ybuf[t * 129 + hl * 64 + pg * 8 + i] + dsk * bf2f(Xt[(hl * 64 + pg * 8 + i) * 72 + t]); g[hl][i] = yy * siluf(z8[i]); ss += g[hl][i] * g[hl][i]; }
    }
    ss += __shfl_xor(ss, 1); ss += __shfl_xor(ss, 2); ss += __shfl_xor(ss, 4);
    const float rs = __builtin_amdgcn_rsqf(ss * (1.f / 128.f) + EPS);
#pragma unroll
    for (int hl = 0; hl < 2; ++hl) {
        const int h = grp * 2 + hl; const float* ng = c.in(I_SN) + l * 256 + h * 64 + pg * 8; float o8[8];
#pragma unroll
        for (int i = 0; i < 8; ++i) o8[i] = g[hl][i] * rs * ng[i];
        st8(c.U + (size_t)(rowbase + t) * UC + UC_SZ + h * 64 + pg * 8, o8);
    }
}

__device__ __forceinline__ void mix_x1_gemm(const Ctx& c, int l, pg8::StaticOrder& S) {
    pg8::Gemm g{c.U + UC_AQ, (const bf16_t*)(c.wb + WB_MLA), R, 1024, 384, UC};
    S.init(R, 1024, gridDim.x, blockIdx.x);
    EpiStore<1024, false> E{c.xn, nullptr}; pg8::gemm_phase<EpiStore<1024, false>, true, false>(c.ldsl, c.tid, g, S, E);
}
__device__ __forceinline__ void mix_x1(const Ctx& c0, int l) {
    constexpr int N_SWA = NB * NCH, N_ML = NB * 4 * NCH, N_SS = NB * 2 * NCH;
    const int vcu1 = (gridDim.x & 7) == 0 ? (int)(blockIdx.x & 7) * (int)(gridDim.x >> 3) + (int)(blockIdx.x >> 3) : (int)blockIdx.x;
    for (int t = vcu1; t < N_SWA + N_ML + N_SS; t += gridDim.x) {
        const Ctx c = retask(c0);
        if (t < N_ML) { const int b = t / (4 * NCH), r = t % (4 * NCH); mlstm_local(c, l, b, r / NCH, r % NCH); }
        else if (t < N_ML + N_SS) { const int u = t - N_ML, b = u / (2 * NCH), r = u % (2 * NCH); ssd_local(c, l, b, r / NCH, r % NCH); }
        else { const int u = t - N_ML - N_SS; swa_prep(c, l, u / NCH, u % NCH); }
    }
}
__device__ __forceinline__ void mix_x2(const Ctx& c, int l) {
    scan_phase(c);
    const int vcu2 = (gridDim.x & 7) == 0 ? (int)(blockIdx.x & 7) * (int)(gridDim.x >> 3) + (int)(blockIdx.x >> 3) : (int)blockIdx.x;
    for (int t = vcu2; t < NB * NCH; t += gridDim.x) { const Ctx cc = retask(c); mla_finish(cc, l, t / NCH, t % NCH); }
}
__device__ __forceinline__ void mix_x3(const Ctx& c0, int l, int part = -1) {
    const bool last = (l == 1);
    const int NL = NB * 4 * 8, NC = last ? 0 : NB * 4;
    const int tc0 = last ? 4 : 0, ntc = NCH - tc0;
    const int N_MLA = NL + NC, N_SWA = NL + NC, N_ML = NB * 4 * ntc, N_SS = NB * 2 * ntc;
    const int vcu = (gridDim.x & 7) == 0 ? (int)(blockIdx.x & 7) * (int)(gridDim.x >> 3) + (int)(blockIdx.x >> 3) : (int)blockIdx.x;
    for (int t = vcu; t < N_MLA + N_SWA + N_ML + N_SS; t += gridDim.x) {
        const Ctx c = retask(c0);
        const bf16_t* QM = (const bf16_t*)(c.ws() + WS_QM); const bf16_t* KM = (const bf16_t*)(c.ws() + WS_KM); const bf16_t* VTM = (const bf16_t*)(c.ws() + WS_VTM);
        const bf16_t* Ksw = (const bf16_t*)(c.ws() + WS_KS); const bf16_t* Vts = (const bf16_t*)(c.ws() + WS_VTS);
        if (part >= 0) { const int ty = t < N_MLA ? 0 : (t < N_MLA + N_SWA ? 1 : (t < N_MLA + N_SWA + N_SS ? 2 : 3)); if (ty != part) continue; }
        if (t < N_MLA) {
            const bool lat = t < NL; const int bh = lat ? (t >> 3) : (t - NL), qb = lat ? (t & 7) : 0, b = bh >> 2, h = bh & 3;
            const int qpos0 = lat ? 256 + qb * 256 : 0, row0 = lat ? b * TL + qb * 256 : RL + b * CL;
            attn_task<96>(c, QM + ((size_t)bh * KEYS + qpos0) * 96, 96, KM + (size_t)bh * KEYS * 96, VTM + (size_t)bh * 64 * KEYS, lat ? 32 : 0, 4, false, 0,
                          0.10206207262f, 0.f, false, c.U + (size_t)row0 * UC + UC_AQ + h * 64, UC);
        } else if (t < N_MLA + N_SWA) {
            const int u = t - N_MLA; const bool lat = u < NL; const int bh = lat ? (u >> 3) : (u - NL), qb = lat ? (u & 7) : 0, b = bh >> 2, h = bh & 3, kv = h >> 1;
            const int t0 = qb * 256, row0 = lat ? b * TL + t0 : RL + b * CL;
            int lo = 0, hi = -1; if (lat) { lo = t0 >= 128 ? (t0 - 128) / 64 : 0; hi = (t0 + 383) / 64; if (hi > 31) hi = 31; }
            bf16_t* qo = c.U + (size_t)row0 * UC + UC_WQ + h * 64;
            attn_task<64>(c, qo, UC, Ksw + (size_t)(b * 2 + kv) * KEYS * 64, Vts + (size_t)(b * 2 + kv) * 64 * KEYS, hi - lo + 1, 4 + lo, true, t0,
                          0.125f, c.in(I_SINK)[l * 4 + h], true, qo, UC);
        } else if (t < N_MLA + N_SWA + N_SS) {
            const int u = t - N_MLA - N_SWA, b = u / (2 * ntc), r = u % (2 * ntc); ssd_out(c, l, b, r / ntc, tc0 + r % ntc);
        } else {
            const int u = t - N_MLA - N_SWA - N_SS, b = u / (4 * ntc), r = u % (4 * ntc); mlstm_out(c, l, b, r / ntc, tc0 + r % ntc);
        }
    }
}

#endif

template <int L, int PT>
__device__ __forceinline__ void do_phase(Ctx& c, const int wv) {
    { int lane; asm volatile("v_mbcnt_lo_u32_b32 %0, -1, 0\n\tv_mbcnt_hi_u32_b32 %0, -1, %0" : "=v"(lane));
      c.lane = lane; c.wave = wv; c.tid = wv * 64 + lane;
      unsigned char* ws = c.ws();
      c.hc = (float*)(ws + WS_HC); c.mod = (float*)(ws + WS_MOD); c.gates = (float*)(ws + WS_GATES); c.wb = ws + WS_WB; c.xn = (bf16_t*)(ws + WS_XN); c.U = (bf16_t*)(ws + WS_U); }
    if constexpr (PT < 0) { mod_phase(c); conv_phase(c, 0); }
    else {
        constexpr int l = L, pt = PT;
        constexpr bool last = (l == 1);
        pg8::StaticOrder S;
        const float* modl = c.mod + (size_t)l * 17 * 9216;
        const float* hl = (l == 0 && pt <= 2) ? c.in(I_X) : c.out();
        const float* hcs = (l == 0 && pt <= 2) ? c.in(I_CTX) : c.hc;
        if constexpr (pt == 0) { if (l > 0) conv_phase(c, l); norm_phase(c, hl, hcs, R, c.in(I_F1N) + l * 1024, modl, 0, 1); }
        else if constexpr (pt == 3) norm_phase(c, hl, hcs, R, c.in(I_MIXN) + l * 1024, modl, 3, 4);
        else if constexpr (pt == 9) norm_phase(c, hl, hcs, last ? RL : R, c.in(I_F2N) + l * 1024, modl, 6, 7);
        else if constexpr (pt == 1 || pt == 10) {
            constexpr int M = (pt == 10 && last) ? RL : R;
            pg8::Gemm g{c.xn, (const bf16_t*)(c.wb + (pt == 1 ? WB_WI1 : WB_WI2)), M, 5632, 1024, 1024};
            S.init(M, 5632, gridDim.x, blockIdx.x);
            EpiSwiglu E{c.U}; pg8::gemm_phase(c.ldsl, c.tid, g, S, E); }
        else if constexpr (pt == 2 || pt == 11) {
            constexpr int M = (pt == 11 && last) ? RL : R;
            pg8::Gemm g{c.U, (const bf16_t*)(c.wb + (pt == 2 ? WB_WO1 : WB_WO2)), M, 1024, 2816, 2816};
            S.init(M, 1024, gridDim.x, blockIdx.x);
            EpiResid E{hl, hcs, c.out(), c.hc, modl, pt == 2 ? 2 : 8, 0.5f}; pg8::gemm_phase(c.ldsl, c.tid, g, S, E); }
        else if constexpr (pt == 4) {
            pg8::Gemm g{c.xn, (const bf16_t*)(c.wb + WB_WIN), R, 2816, 1024, 1024};
            S.init(R, 2816, gridDim.x, blockIdx.x);
            EpiStore<UC, true> E{c.U, c.gates}; pg8::gemm_phase(c.ldsl, c.tid, g, S, E); }
#if N_MIX
        else if constexpr (pt == 5) mix_x1_gemm(c, l, S);
        else if constexpr (pt == 12) mix_x1(c, l);
        else if constexpr (pt == 6) mix_x2(c, l);
        else if constexpr (pt == 7) mix_x3(c, l);
        else if constexpr (pt >= 13 && pt <= 16) mix_x3(c, l, pt - 13);
        else if constexpr (pt == 8) {
            constexpr int M = last ? RL : R;
            pg8::Gemm g{c.U, (const bf16_t*)(c.wb + WB_WOUT), M, 1024, 1024, UC};
            S.init(M, 1024, gridDim.x, blockIdx.x);
            EpiResid E{hl, hcs, c.out(), c.hc, modl, 5, 1.0f}; pg8::gemm_phase(c.ldsl, c.tid, g, S, E); }
#endif
    }
}

#define XB_TMO      128
#define XB_XCNT(j)  (256  + 64 * (j))
#define XB_XSUB(j)  (1280 + 64 * (j))
#define XB_XGEN(j)  (2304 + 64 * (j))
#define XB_TOP      3328
#define XB_TOPGEN   3392
#define XCD_BAR_WORDS 3456
#define XB_SPIN_CAP (1u << 18)
__device__ __forceinline__ unsigned xb_ld(unsigned* p)              { return __hip_atomic_load(p, __ATOMIC_RELAXED, __HIP_MEMORY_SCOPE_AGENT); }
__device__ __forceinline__ unsigned xb_add(unsigned* p, unsigned v) { return __hip_atomic_fetch_add(p, v, __ATOMIC_RELAXED, __HIP_MEMORY_SCOPE_AGENT); }
__device__ __forceinline__ unsigned xb_xcc_id() { return (unsigned)__builtin_amdgcn_s_getreg((3 << 11) | 20) & 0xFu; }
#define XB_SPIN(cond, bar) do { unsigned _sp = 0; while (cond) { __builtin_amdgcn_s_sleep(1); \
    if ((++_sp & 255u) == 0u) { if (xb_ld(&(bar)[XB_TMO])) break; if (_sp > XB_SPIN_CAP) { atomicAdd(&(bar)[XB_TMO], 1u); break; } } } } while (0)
__device__ __forceinline__ void xcd_barrier_complete(unsigned* bar, unsigned x, unsigned& nloc, unsigned& nx) {
    const unsigned G = gridDim.x * gridDim.y * gridDim.z;
    unsigned sum, cnt, mine, sp = 0u;
    for (;;) {
        sum = 0u; cnt = 0u; mine = 0u;
#pragma unroll
        for (unsigned j = 0; j < 16; ++j) { const unsigned cc = xb_ld(&bar[XB_XCNT(j)]); sum += cc; cnt += (cc > 0u) ? 1u : 0u; mine = (j == x) ? cc : mine; }
        if (sum == G) break;
        __builtin_amdgcn_s_sleep(1);
        if ((++sp & 255u) == 0u) { if (xb_ld(&bar[XB_TMO])) break; if (sp > XB_SPIN_CAP) { atomicAdd(&bar[XB_TMO], 1u); break; } }
    }
    nloc = mine > 0u ? mine : 1u; nx = cnt > 0u ? cnt : 1u;
}
__device__ __forceinline__ void xcd_barrier(unsigned* bar, const unsigned x, volatile LAS unsigned* st, const bool leader_thread) {
    asm volatile("s_waitcnt vmcnt(0)" ::: "memory");
    __syncthreads();
    if (leader_thread) {
        __builtin_amdgcn_s_waitcnt(0);
        unsigned nloc = st[0], nx = st[1];
        if (nloc == 0u) { xcd_barrier_complete(bar, x, nloc, nx); st[0] = nloc; st[1] = nx; }
        const unsigned old = xb_add(&bar[XB_XSUB(x)], 1u);
        const unsigned gen = old / nloc;
        if (old + 1u == (gen + 1u) * nloc) {
            __builtin_amdgcn_fence(__ATOMIC_RELEASE, "agent");
            asm volatile("s_waitcnt vmcnt(0)" ::: "memory");
            const unsigned og = xb_add(&bar[XB_TOP], 1u);
            const unsigned tg = og / nx;
            if (og + 1u == (tg + 1u) * nx) xb_add(&bar[XB_TOPGEN], 1u);
            else XB_SPIN(xb_ld(&bar[XB_TOPGEN]) == tg, bar);
            __builtin_amdgcn_fence(__ATOMIC_ACQUIRE, "agent");
            xb_add(&bar[XB_XGEN(x)], 1u);
            asm volatile("s_waitcnt vmcnt(0)" ::: "memory");
        } else {
            XB_SPIN(xb_ld(&bar[XB_XGEN(x)]) == gen, bar);
            __builtin_amdgcn_fence(__ATOMIC_ACQUIRE, "agent");
            asm volatile("s_waitcnt vmcnt(0)" ::: "memory");
        }
    }
    __syncthreads();
}

__global__ void __launch_bounds__(NTHR, 2) mega(Params p) {
    extern __shared__ __attribute__((aligned(16))) unsigned char smem[];
    cg::grid_group grid = cg::this_grid();
    Ctx c; c.lds = smem; c.ldsl = (LAS unsigned char*)smem;
    { LAS unsigned long long* pl = (LAS unsigned long long*)(c.ldsl + PARAM_OFF); const int t0 = threadIdx.x;
      if (t0 < 32) pl[t0] = (unsigned long long)p.in[t0]; else if (t0 == 32) pl[32] = (unsigned long long)p.out; else if (t0 == 33) pl[33] = (unsigned long long)p.ws; }
    volatile LAS unsigned* const xst = (volatile LAS unsigned*)(c.ldsl + PARAM_OFF + 448);
    if (threadIdx.x == 64) { xst[0] = 0u; xst[1] = 0u; }
    unsigned* const bar = (unsigned*)(p.ws + WS_BAR);
    const unsigned xcc = xb_xcc_id();
    if (threadIdx.x == 0) (void)xb_add(&bar[XB_XCNT(xcc)], 1u);
    __syncthreads();
    const int ph_lo = p.ph_lo, ph_hi = p.ph_hi;
    const int wv = __builtin_amdgcn_readfirstlane(threadIdx.x >> 6);
#ifdef PROBE_SUB
#define RUN(PH, L, PT) if (ph_lo <= (PH) && (PH) < ph_hi) { if (PT == 7) { const unsigned long long tz_ = __builtin_amdgcn_s_memrealtime(); \
      do_phase<L, (PT == 7 ? 13 : PT)>(c, wv); grid.sync(); unsigned long long ta_ = __builtin_amdgcn_s_memrealtime(); do_phase<L, (PT == 7 ? 14 : PT)>(c, wv); grid.sync(); unsigned long long tb_ = __builtin_amdgcn_s_memrealtime(); \
      do_phase<L, (PT == 7 ? 15 : PT)>(c, wv); grid.sync(); unsigned long long tc_ = __builtin_amdgcn_s_memrealtime(); do_phase<L, (PT == 7 ? 16 : PT)>(c, wv); grid.sync(); unsigned long long td_ = __builtin_amdgcn_s_memrealtime(); \
      const unsigned long long w_ = PROBE_SUB == 9 ? 0ull : PROBE_SUB == 0 ? ta_ - tz_ : PROBE_SUB == 1 ? tb_ - ta_ : (PROBE_SUB == 2 ? tc_ - tb_ : (PROBE_SUB == 3 ? td_ - tc_ : (td_ - ta_))); \
      if (blockIdx.x == 0) { while (__builtin_amdgcn_s_memrealtime() - td_ < w_) __builtin_amdgcn_s_sleep(8); } } \
    else { do_phase<L, PT>(c, wv); if (PT == 5) do_phase<L, 12>(c, wv); if ((PH) + 1 < ph_hi) grid.sync(); } }
#elif defined(PROBE_PT)
#define RUN(PH, L, PT) if (ph_lo <= (PH) && (PH) < ph_hi) { const unsigned long long t0_ = __builtin_amdgcn_s_memrealtime(); do_phase<L, PT>(c, wv); if (PT == 5) do_phase<L, 12>(c, wv); grid.sync(); \
    if (PT == PROBE_PT && blockIdx.x == 0) { const unsigned long long t1_ = __builtin_amdgcn_s_memrealtime(); while (__builtin_amdgcn_s_memrealtime() - t1_ < (t1_ - t0_)) __builtin_amdgcn_s_sleep(8); } }
#else
#define RUN(PH, L, PT) if (ph_lo <= (PH) && (PH) < ph_hi) { do_phase<L, PT>(c, wv); if (PT == 5) do_phase<L, 12>(c, wv); if ((PH) + 1 < ph_hi) { if ((PH) == 0) grid.sync(); else { int ln_; asm volatile("v_mbcnt_lo_u32_b32 %0, -1, 0\n\tv_mbcnt_hi_u32_b32 %0, -1, %0" : "=v"(ln_)); xcd_barrier(bar, xcc, xst, wv == 0 && ln_ == 0); } } }
#endif
    RUN(0, 0, -1)
    RUN(1, 0, 0) RUN(2, 0, 1) RUN(3, 0, 2) RUN(4, 0, 3) RUN(5, 0, 4) RUN(6, 0, 5) RUN(7, 0, 6) RUN(8, 0, 7) RUN(9, 0, 8) RUN(10, 0, 9) RUN(11, 0, 10) RUN(12, 0, 11)
    RUN(13, 1, 0) RUN(14, 1, 1) RUN(15, 1, 2) RUN(16, 1, 3) RUN(17, 1, 4) RUN(18, 1, 5) RUN(19, 1, 6) RUN(20, 1, 7) RUN(21, 1, 8) RUN(22, 1, 9) RUN(23, 1, 10) RUN(24, 1, 11)
#undef RUN
}

extern "C" void kernel_launch(void* const* d_in, const int* in_sizes, int n_in, void* d_out, int out_size, void* d_ws, size_t ws_size, hipStream_t stream) {
    static int grid = 0;
    if (grid == 0) {
        if (n_in != 32 || ws_size < WS_END) { fprintf(stderr, "kernel_launch: unexpected n_in %d / ws_size %zu (need %zu)\n", n_in, ws_size, (size_t)WS_END); grid = -1; return; }
        int dev = 0, cus = 0, per_cu = 0;
        hipGetDevice(&dev);
        hipDeviceGetAttribute(&cus, hipDeviceAttributeMultiprocessorCount, dev);
        hipFuncSetAttribute((const void*)mega, hipFuncAttributeMaxDynamicSharedMemorySize, LDS_BYTES);
        hipOccupancyMaxActiveBlocksPerMultiprocessor(&per_cu, (const void*)mega, NTHR, LDS_BYTES);
        if (per_cu < 1) per_cu = 1;
        grid = cus;
        (void)hipGetLastError();
    }
    if (grid < 0) return;
    Params p{};
    for (int i = 0; i < 32; ++i) p.in[i] = (const float*)d_in[i];
    p.out = (float*)d_out; p.ws = (unsigned char*)d_ws; p.ph_lo = 0; p.ph_hi = 25;
    if (hipMemsetAsync((char*)d_ws + WS_BAR, 0, 16384, stream) != hipSuccess) { fprintf(stderr, "kernel_launch: memset of the barrier words failed\n"); return; }
    void* args[] = {&p};
    hipError_t e = hipLaunchCooperativeKernel((const void*)mega, dim3(grid), dim3(NTHR), args, LDS_BYTES, stream);
    if (e != hipSuccess) fprintf(stderr, "cooperative launch failed: %s (grid %d)\n", hipGetErrorString(e), grid);
}
```

```cpp
#include <hip/hip_runtime.h>
#include <hip/hip_cooperative_groups.h>
#include <cstdio>
#include <cstdint>
namespace cg = cooperative_groups;

#define LAS __attribute__((address_space(3)))
typedef unsigned short bf16_t;
typedef short bf16x8 __attribute__((ext_vector_type(8)));
typedef float f32x4 __attribute__((ext_vector_type(4)));
typedef unsigned u32x4 __attribute__((ext_vector_type(4)));
typedef unsigned u32x2 __attribute__((ext_vector_type(2)));

#ifndef N_MIX
#define N_MIX 1
#endif

constexpr int D = 1024, NB = 16, TL = 2048, CL = 256, RL = NB * TL, RC = NB * CL, R = RL + RC;
constexpr int FF = 2816, UC = 2816, KEYS = CL + TL, NCH = KEYS / 64;
constexpr float EPS = 1e-6f;
constexpr int NTHR = 512;
constexpr int LDS_BYTES = 147456;
constexpr int UC_MQ = 0, UC_WQ = 256, UC_SZ = 512, UC_AQ = 768, UC_AKV = 1024, UC_AKR = 1152, UC_MK = 1184, UC_MV = 1440, UC_MO = 1696,
              UC_WK = 1952, UC_WV = 2080, UC_XBC = 2208, UC_MG = 2720, UC_DT = 2736;
constexpr size_t WS_HC = 0;
constexpr size_t WS_MOD = WS_HC + (size_t)RC * D * 4;
constexpr size_t WS_GATES = WS_MOD + (size_t)2 * 17 * 9216 * 4;
constexpr size_t WS_WB = WS_GATES + (size_t)R * 32 * 4;
constexpr size_t WB_WI1 = 0, WB_WO1 = WB_WI1 + (size_t)5632 * 1024 * 2, WB_WIN = WB_WO1 + (size_t)1024 * 2816 * 2, WB_WOUT = WB_WIN + (size_t)2816 * 1024 * 2,
                 WB_WI2 = WB_WOUT + (size_t)1024 * 1024 * 2, WB_WO2 = WB_WI2 + (size_t)5632 * 1024 * 2, WB_MLA = WB_WO2 + (size_t)1024 * 2816 * 2, WB_END = WB_MLA + (size_t)1024 * 384 * 2;
constexpr size_t WS_XN = WS_WB + WB_END;
constexpr size_t WS_U = WS_XN + (size_t)R * 1024 * 2;
constexpr size_t WS_STM = WS_U + (size_t)R * UC * 2;
constexpr size_t WS_STS = WS_STM + (size_t)NB * 4 * 2 * NCH * 4160 * 2;
constexpr size_t WS_DECM = WS_STS + (size_t)NB * 4 * 2 * NCH * 4096 * 2;
constexpr size_t WS_DECS = WS_DECM + (size_t)NB * 4 * 2 * NCH * 4;
constexpr size_t WS_QM = WS_DECS + (size_t)NB * 4 * 2 * NCH * 4;
constexpr size_t WS_KM = WS_QM + (size_t)NB * 4 * KEYS * 96 * 2;
constexpr size_t WS_VTM = WS_KM + (size_t)NB * 4 * KEYS * 96 * 2;
constexpr size_t WS_KS = WS_VTM + (size_t)NB * 4 * 64 * KEYS * 2;
constexpr size_t WS_VTS = WS_KS + (size_t)NB * 2 * KEYS * 64 * 2;
constexpr size_t WS_BAR = WS_VTS + (size_t)NB * 2 * 64 * KEYS * 2;
constexpr size_t WS_END = WS_BAR + 16384;

struct Params { const float* in[32]; float* out; unsigned char* ws; int ph_lo, ph_hi; };
enum { I_X = 0, I_C, I_CTX, I_CCTX, I_WMOD, I_BMOD, I_F1N, I_F1WI, I_F1WO, I_MIXN, I_WIN, I_WOUT, I_MGB, I_MON, I_AQN, I_AKVN, I_AWQ, I_AWKV, I_AQG, I_AKG,
       I_SQG, I_SKG, I_SINK, I_CW, I_CB, I_DTB, I_ALOG, I_SD, I_SN, I_F2N, I_F2WI, I_F2WO };

__device__ __forceinline__ float bf2f(bf16_t v) { return __uint_as_float((unsigned)v << 16); }
__device__ __forceinline__ bf16_t f2bf(float f) { unsigned u = __float_as_uint(f); return (bf16_t)((u + 0x7fffu + ((u >> 16) & 1u)) >> 16); }
typedef float f32x2_t __attribute__((ext_vector_type(2)));
typedef __bf16 bf16x2_t __attribute__((ext_vector_type(2)));
__device__ __forceinline__ unsigned pk2(float lo, float hi) { const f32x2_t v = {lo, hi}; const bf16x2_t b = __builtin_convertvector(v, bf16x2_t); return __builtin_bit_cast(unsigned, b); }
template <int CTRL> __device__ __forceinline__ float dppf(float v) { return __int_as_float(__builtin_amdgcn_update_dpp(0, __float_as_int(v), CTRL, 0xf, 0xf, true)); }
__device__ __forceinline__ float row16_max(float v) { v = fmaxf(v, dppf<0x128>(v)); v = fmaxf(v, dppf<0x124>(v)); v = fmaxf(v, dppf<0x122>(v)); return fmaxf(v, dppf<0x121>(v)); }
__device__ __forceinline__ float row16_sum(float v) { v += dppf<0x128>(v); v += dppf<0x124>(v); v += dppf<0x122>(v); return v + dppf<0x121>(v); }
__device__ __forceinline__ float wave_sum(float v) {
    v = row16_sum(v); v += __shfl_xor(v, 16); v += __shfl_xor(v, 32); return v;
}
__device__ __forceinline__ float siluf(float x) { return x * __builtin_amdgcn_rcpf(1.f + __builtin_amdgcn_exp2f(x * -1.44269504089f)); }
__device__ __forceinline__ float sigmf(float x) { return __builtin_amdgcn_rcpf(1.f + __builtin_amdgcn_exp2f(x * -1.44269504089f)); }
__device__ __forceinline__ float logsigf(float x) { return fminf(x, 0.f) - log1pf(__expf(-fabsf(x))); }
__device__ __forceinline__ float softplusf(float x) { return fmaxf(x, 0.f) + log1pf(__expf(-fabsf(x))); }

namespace pg8 {
constexpr int BM = 256, BK = 64, HALF = 128, HTB = HALF * BK * 2, STAGE_BYTES = 8 * HTB, NXCD = 8, WGM = 8;
__host__ __device__ __forceinline__ int lds_byte(int r, int c) { const int st = (r >> 4) * 2 + (c >> 5), rr = r & 15, cc = c & 31, ob = rr * 64 + cc * 2; return st * 1024 + (ob ^ (((ob >> 9) & 1) << 5)); }
__host__ __device__ __forceinline__ void stage_rc(int b, int& Rr, int& C) { const int st = b / 1024, sb = b % 1024, swz = sb ^ (((sb >> 9) & 1) << 5); Rr = (st >> 1) * 16 + swz / 64; C = (st & 1) * 32 + (swz % 64) / 2; }
__host__ __device__ __forceinline__ int perm32(int rho) { const int n = rho >> 4, i = rho & 15; return 8 * (i >> 2) + 4 * n + (i & 3); }
struct Unit { int pm, pn; };
struct Gemm { const bf16_t* A; const bf16_t* Bt; int M, N, K, lda; };
struct StaticOrder {
    int nM, nN, nwg, G, c;
    __device__ void init(int M, int N, int G_, int c_) { nM = M / BM; nN = N / BM; nwg = nM * nN; G = G_; c = c_; }
    __device__ bool next(int i, Unit& u) const {
        const long L = (long)i * G + c; if (L >= nwg) return false;
        int wgid = (int)L; { const int q = nwg / NXCD, r = nwg % NXCD, xcd = wgid % NXCD, off = wgid / NXCD; wgid = (xcd < r ? xcd * (q + 1) : r * (q + 1) + (xcd - r) * q) + off; }
        const int nig = WGM * nN, gid = wgid / nig, fm = gid * WGM, gsz = (nM - fm) < WGM ? (nM - fm) : WGM;
        u.pm = fm + ((wgid % nig) % gsz); u.pn = (wgid % nig) / gsz; return true;
    }
};
template <class Epi, bool SP2 = true, bool ALIGN_EPI = true>
__device__ __forceinline__ void gemm_phase(LAS unsigned char* lds, const int tid, const Gemm g, const StaticOrder& S, const Epi& E) {
    const int wid = __builtin_amdgcn_readfirstlane(tid >> 6), lane = tid & 63, wr = wid >> 2, wc = wid & 3, fr = lane & 15, fq = lane >> 4;
    const int K = g.K, nt = K / BK, lda = g.lda;
    unsigned voffA_, voffB_;
    { int Rr, C; stage_rc(tid * 16, Rr, C); const int Rb = Epi::PERM ? ((Rr & ~31) + perm32(Rr & 31)) : Rr;
      voffA_ = (unsigned)(Rr * lda + C) * 2u; voffB_ = (unsigned)(Rb * K + C) * 2u; }
    const unsigned v_offA = voffA_, v_offB = voffB_;
    const size_t r64offA = (size_t)64 * lda * 2, r64offB = (size_t)64 * K * 2;
    const size_t kstep = (size_t)(BK * 2);
    const size_t hstepA = (size_t)HALF * lda * 2, hstepB = (size_t)HALF * K * 2;
    const size_t tstepA = 2 * hstepA, tstepB = 2 * hstepB;
    const unsigned ldsw = (unsigned)wid * 1024u;
    const int aoff = lds_byte(wr * 64 + fr, fq * 8), boff = lds_byte(wc * 32 + fr, fq * 8);
#define PG8_SA(b, h) (((b) * 2 + (h)) * HTB)
#define PG8_SB(b, h) ((4 + (b) * 2 + (h)) * HTB)
#define PG8_STAGE(bufoff, gbase, voff) do { _Pragma("unroll") for (int _i = 0; _i < 2; ++_i) \
        __builtin_amdgcn_global_load_lds((const unsigned*)((const char*)(gbase) + _i * r64##voff + v_##voff), (LAS unsigned*)(lds + (bufoff) + ldsw + _i * 8192), 16, 0, 0); } while (0)
#define PG8_LDA(dst, b, h) do { _Pragma("unroll") for (int m = 0; m < 4; ++m) _Pragma("unroll") for (int k = 0; k < 2; ++k) dst[m][k] = *(const LAS bf16x8*)(lds + PG8_SA(b, h) + aoff + m * 2048 + k * 1024); } while (0)
#define PG8_LDB(dst, b, h) do { _Pragma("unroll") for (int n = 0; n < 2; ++n) _Pragma("unroll") for (int k = 0; k < 2; ++k) dst[n][k] = *(const LAS bf16x8*)(lds + PG8_SB(b, h) + boff + n * 2048 + k * 1024); } while (0)
#define PG8_MMA(ai, bj, At, Bt) do { __builtin_amdgcn_s_setprio(1); _Pragma("unroll") for (int m = 0; m < 4; ++m) _Pragma("unroll") for (int n = 0; n < 2; ++n) _Pragma("unroll") for (int k = 0; k < 2; ++k) \
        acc[ai][bj][m][n] = __builtin_amdgcn_mfma_f32_16x16x32_bf16(Bt[n][k], At[m][k], acc[ai][bj][m][n], 0, 0, 0); __builtin_amdgcn_s_setprio(0); } while (0)
#define PG8_WAIT_V(n) asm volatile("s_waitcnt vmcnt(" #n ")" ::: "memory")
#define PG8_WAIT_L(n) asm volatile("s_waitcnt lgkmcnt(" #n ")" ::: "memory")
#define PG8_BAR __builtin_amdgcn_s_barrier()
#define PG8_SCHED __builtin_amdgcn_sched_barrier(0)
    Unit cur, nxt; int ui = 0;
    if (!S.next(0, cur)) return;
    f32x4 acc[2][2][4][2];
#pragma unroll
    for (int a = 0; a < 2; ++a)
#pragma unroll
        for (int b = 0; b < 2; ++b)
#pragma unroll
            for (int m = 0; m < 4; ++m)
#pragma unroll
                for (int n = 0; n < 2; ++n) acc[a][b][m][n] = (f32x4){0.f, 0.f, 0.f, 0.f};
    bf16x8 At[4][2], B0[2][2], B1[2][2];
    const char* cA = (const char*)g.A + (size_t)cur.pm * tstepA; const char* cB = (const char*)g.Bt + (size_t)cur.pn * tstepB;
    if constexpr (SP2) {
        PG8_STAGE(PG8_SB(0, 0), cB, offB); PG8_STAGE(PG8_SB(0, 1), cB + hstepB, offB); PG8_STAGE(PG8_SA(0, 0), cA, offA); PG8_STAGE(PG8_SA(0, 1), cA + hstepA, offA);
        if (wr == 1) PG8_BAR;
        PG8_WAIT_V(2); PG8_BAR;
        PG8_STAGE(PG8_SB(1, 0), cB + kstep, offB); PG8_STAGE(PG8_SA(1, 0), cA + kstep, offA); PG8_STAGE(PG8_SB(1, 1), cB + hstepB + kstep, offB);
        PG8_WAIT_V(6); PG8_BAR;
    } else {
    PG8_STAGE(PG8_SB(0, 0), cB, offB); PG8_STAGE(PG8_SA(0, 0), cA, offA); PG8_STAGE(PG8_SB(0, 1), cB + hstepB, offB); PG8_STAGE(PG8_SA(0, 1), cA + hstepA, offA);
    if (wr == 1) PG8_BAR;
    PG8_WAIT_V(4); PG8_BAR;
    PG8_STAGE(PG8_SB(1, 0), cB + kstep, offB); PG8_STAGE(PG8_SA(1, 0), cA + kstep, offA); PG8_STAGE(PG8_SB(1, 1), cB + hstepB + kstep, offB);
    PG8_WAIT_V(6); PG8_BAR;
    }
    for (;;) {
        const bool has_next = S.next(ui + 1, nxt);
        const char* nA = has_next ? (const char*)g.A + (size_t)nxt.pm * tstepA : cA; const char* nB = has_next ? (const char*)g.Bt + (size_t)nxt.pn * tstepB : cB;
        for (int t = 0; t < nt; t += 2) {
            const bool last = (t == nt - 2);
            const char* a1 = cA + (size_t)(t + 1) * kstep;
            const char* a2 = last ? nA : cA + (size_t)(t + 2) * kstep; const char* b2 = last ? nB : cB + (size_t)(t + 2) * kstep;
            const char* a3 = a2 + kstep; const char* b3 = b2 + kstep;
            if constexpr (SP2) {
            PG8_LDB(B0, 0, 0); PG8_LDB(B1, 0, 1); PG8_SCHED; PG8_LDA(At, 0, 0); PG8_STAGE(PG8_SA(1, 1), a1 + hstepA, offA);
            PG8_WAIT_V(8); PG8_WAIT_L(0); PG8_BAR; PG8_MMA(0, 0, At, B0); PG8_MMA(0, 1, At, B1); PG8_BAR; PG8_SCHED;
            PG8_LDA(At, 0, 1); PG8_STAGE(PG8_SB(0, 0), b2, offB); PG8_STAGE(PG8_SB(0, 1), b2 + hstepB, offB); PG8_STAGE(PG8_SA(0, 0), a2, offA);
            PG8_WAIT_V(8); PG8_WAIT_L(0); PG8_BAR; PG8_MMA(1, 0, At, B0); PG8_MMA(1, 1, At, B1); PG8_BAR; PG8_SCHED;
            PG8_LDB(B0, 1, 0); PG8_LDB(B1, 1, 1); PG8_SCHED; PG8_LDA(At, 1, 0); PG8_STAGE(PG8_SA(0, 1), a2 + hstepA, offA);
            PG8_WAIT_V(8); PG8_WAIT_L(0); PG8_BAR; PG8_MMA(0, 0, At, B0); PG8_MMA(0, 1, At, B1); PG8_BAR; PG8_SCHED;
            PG8_LDA(At, 1, 1); PG8_STAGE(PG8_SB(1, 0), b3, offB); PG8_STAGE(PG8_SB(1, 1), b3 + hstepB, offB); PG8_STAGE(PG8_SA(1, 0), a3, offA);
            PG8_WAIT_V(8); PG8_WAIT_L(0); PG8_BAR; PG8_MMA(1, 0, At, B0); PG8_MMA(1, 1, At, B1); PG8_BAR; PG8_SCHED;
            } else {
            PG8_LDB(B0, 0, 0); PG8_SCHED; PG8_LDA(At, 0, 0); PG8_STAGE(PG8_SA(1, 1), a1 + hstepA, offA);
            PG8_WAIT_L(8); PG8_BAR; PG8_WAIT_L(0); PG8_MMA(0, 0, At, B0); PG8_BAR; PG8_SCHED;
            PG8_LDB(B1, 0, 1); PG8_STAGE(PG8_SB(0, 0), b2, offB);
            PG8_BAR; PG8_WAIT_L(0); PG8_MMA(0, 1, At, B1); PG8_BAR;
            PG8_LDA(At, 0, 1); PG8_STAGE(PG8_SA(0, 0), a2, offA);
            PG8_BAR; PG8_WAIT_L(0); PG8_MMA(1, 0, At, B0); PG8_BAR; PG8_SCHED;
            PG8_STAGE(PG8_SB(0, 1), b2 + hstepB, offB);
            PG8_WAIT_V(6); PG8_BAR; PG8_MMA(1, 1, At, B1); PG8_BAR;
            PG8_LDB(B0, 1, 0); PG8_SCHED; PG8_LDA(At, 1, 0); PG8_STAGE(PG8_SA(0, 1), a2 + hstepA, offA);
            PG8_WAIT_L(8); PG8_BAR; PG8_WAIT_L(0); PG8_MMA(0, 0, At, B0); PG8_BAR; PG8_SCHED;
            PG8_LDB(B1, 1, 1); PG8_STAGE(PG8_SB(1, 0), b3, offB);
            PG8_BAR; PG8_WAIT_L(0); PG8_MMA(0, 1, At, B1); PG8_BAR;
            PG8_LDA(At, 1, 1); PG8_STAGE(PG8_SA(1, 0), a3, offA);
            PG8_BAR; PG8_WAIT_L(0); PG8_MMA(1, 0, At, B0); PG8_BAR; PG8_SCHED;
            PG8_STAGE(PG8_SB(1, 1), b3 + hstepB, offB);
            PG8_WAIT_V(6); PG8_BAR; PG8_MMA(1, 1, At, B1); PG8_BAR;
            }
        }
        if constexpr (ALIGN_EPI) { if (wr == 0) PG8_BAR; }
        E(acc, cur, wr, wc, fr, fq);
        if (!has_next) break;
#pragma unroll
        for (int a = 0; a < 2; ++a)
#pragma unroll
            for (int b = 0; b < 2; ++b)
#pragma unroll
                for (int m = 0; m < 4; ++m)
#pragma unroll
                    for (int n = 0; n < 2; ++n) acc[a][b][m][n] = (f32x4){0.f, 0.f, 0.f, 0.f};
        cur = nxt; cA = nA; cB = nB; ++ui;
        if constexpr (ALIGN_EPI) { if (wr == 1) PG8_BAR; }
    }
    PG8_WAIT_V(0);
    if constexpr (!ALIGN_EPI) { if (wr == 0) PG8_BAR; }
    PG8_BAR;
#undef PG8_SA
#undef PG8_SB
#undef PG8_STAGE
#undef PG8_LDA
#undef PG8_LDB
#undef PG8_MMA
#undef PG8_WAIT_V
#undef PG8_WAIT_L
#undef PG8_BAR
#undef PG8_SCHED
}
}

struct EpiSwiglu {
    static constexpr bool PERM = true;
    bf16_t* act;
    __device__ __forceinline__ void operator()(const f32x4 (&acc)[2][2][4][2], const pg8::Unit& u, int wr, int wc, int fr, int fq) const {
        const int row0 = u.pm * 256 + wr * 64 + fr, col0 = u.pn * 128 + wc * 32 + 8 * fq;
#pragma unroll
        for (int ai = 0; ai < 2; ++ai)
#pragma unroll
            for (int m = 0; m < 4; ++m) {
                bf16_t* rowp = act + (size_t)(row0 + ai * 128 + m * 16) * FF + col0;
                const f32x4 g0 = acc[ai][0][m][0], g1 = acc[ai][0][m][1], u0 = acc[ai][1][m][0], u1 = acc[ai][1][m][1];
                u32x4 w;
                w.x = pk2(siluf(g0[0]) * u0[0], siluf(g0[1]) * u0[1]); w.y = pk2(siluf(g0[2]) * u0[2], siluf(g0[3]) * u0[3]);
                w.z = pk2(siluf(g1[0]) * u1[0], siluf(g1[1]) * u1[1]); w.w = pk2(siluf(g1[2]) * u1[2], siluf(g1[3]) * u1[3]);
                *(u32x4*)rowp = w;
            }
    }
};
struct EpiResid {
    static constexpr bool PERM = false;
    const float* srcl; const float* srcc; float* dstl; float* dstc; const float* mod; int gi; float sc;
    __device__ __forceinline__ void operator()(const f32x4 (&acc)[2][2][4][2], const pg8::Unit& u, int wr, int wc, int fr, int fq) const {
        const int row0 = u.pm * 256 + wr * 64 + fr;
        const bool lat = u.pm < (RL / 256);
        const int bi = lat ? (u.pm >> 3) : 16;
        const float* g = mod + (size_t)(bi * 9 + gi) * 1024 + u.pn * 256 + wc * 32 + fq * 4;
        const size_t ro = (lat ? (size_t)row0 : (size_t)(row0 - RL)) * 1024 + u.pn * 256 + wc * 32 + fq * 4;
        const float* sp = (lat ? srcl : srcc) + ro; float* dp = (lat ? dstl : dstc) + ro;
        f32x4 gg[2][2];
#pragma unroll
        for (int bj = 0; bj < 2; ++bj)
#pragma unroll
            for (int n = 0; n < 2; ++n) gg[bj][n] = *(const f32x4*)(g + bj * 128 + n * 16) * sc;
#pragma unroll
        for (int ai = 0; ai < 2; ++ai) {
            f32x4 h[4][2][2];
#pragma unroll
            for (int m = 0; m < 4; ++m)
#pragma unroll
                for (int bj = 0; bj < 2; ++bj)
#pragma unroll
                    for (int n = 0; n < 2; ++n) h[m][bj][n] = *(const f32x4*)(sp + (size_t)(ai * 128 + m * 16) * 1024 + bj * 128 + n * 16);
#pragma unroll
            for (int m = 0; m < 4; ++m)
#pragma unroll
                for (int bj = 0; bj < 2; ++bj)
#pragma unroll
                    for (int n = 0; n < 2; ++n) *(f32x4*)(dp + (size_t)(ai * 128 + m * 16) * 1024 + bj * 128 + n * 16) = h[m][bj][n] + gg[bj][n] * acc[ai][bj][m][n];
        }
    }
};
template <int LDC, bool GATES>
struct EpiStore {
    static constexpr bool PERM = true;
    bf16_t* O; float* gates;
    __device__ __forceinline__ void operator()(const f32x4 (&acc)[2][2][4][2], const pg8::Unit& u, int wr, int wc, int fr, int fq) const {
        const int row0 = u.pm * 256 + wr * 64 + fr, col0 = u.pn * 256 + wc * 32 + 8 * fq;
        bf16_t* base = O + (size_t)row0 * LDC + col0;
#pragma unroll
        for (int ai = 0; ai < 2; ++ai)
#pragma unroll
            for (int m = 0; m < 4; ++m) {
#pragma unroll
                for (int bj = 0; bj < 2; ++bj) {
                    const f32x4 v0 = acc[ai][bj][m][0], v1 = acc[ai][bj][m][1];
                    u32x4 w; w.x = pk2(v0[0], v0[1]); w.y = pk2(v0[2], v0[3]); w.z = pk2(v1[0], v1[1]); w.w = pk2(v1[2], v1[3]);
                    *(u32x4*)(base + (ai * 128 + m * 16) * LDC + bj * 128) = w;
                }
            }
        if (GATES) {
            if (u.pn == 10 && wc == 1 && fq < 3) {
                float* gp = gates + (size_t)row0 * 32 + 8 * fq;
#pragma unroll
                for (int ai = 0; ai < 2; ++ai)
#pragma unroll
                    for (int m = 0; m < 4; ++m) { *(f32x4*)(gp + (ai * 128 + m * 16) * 32) = acc[ai][1][m][0]; *(f32x4*)(gp + (ai * 128 + m * 16) * 32 + 4) = acc[ai][1][m][1]; }
            }
        }
    }
};
static_assert(UC_MG == 2560 + 128 + 32, "gate columns sit at tile 10, bj 1, wc 1");

constexpr int PARAM_OFF = LDS_BYTES - 512;
struct Ctx {
    unsigned char* lds; LAS unsigned char* ldsl; int tid, lane, wave;
    float* hc; float* mod; float* gates; unsigned char* wb; bf16_t* xn; bf16_t* U;
    __device__ __forceinline__ unsigned long long ptr(int i) const {
        const LAS unsigned* q = (const LAS unsigned*)(ldsl + PARAM_OFF) + 2 * i;
        const unsigned lo = __builtin_amdgcn_readfirstlane(q[0]), hi = __builtin_amdgcn_readfirstlane(q[1]);
        return ((unsigned long long)hi << 32) | lo; }
    __device__ __forceinline__ const float* in(int i) const { return (const float*)ptr(i); }
    __device__ __forceinline__ float* out() const { return (float*)ptr(32); }
    __device__ __forceinline__ unsigned char* ws() const { return (unsigned char*)ptr(33); }
};

__device__ __forceinline__ Ctx retask(const Ctx& c) {
    Ctx r = c; int lane; asm volatile("v_mbcnt_lo_u32_b32 %0, -1, 0\n\tv_mbcnt_hi_u32_b32 %0, -1, %0" : "=v"(lane));
    r.lane = lane; r.tid = c.wave * 64 + lane; return r;
}

__device__ __forceinline__ void mod_phase(const Ctx& c) {
    float* sc = (float*)c.lds;
    float* red = sc + 17 * 1024;
    const float* cv = c.in(I_C); const float* cc = c.in(I_CCTX);
    for (int i = c.tid; i < 17 * 1024; i += NTHR) { const int bi = i >> 10, k = i & 1023; const float v = bi < 16 ? cv[bi * 1024 + k] : cc[k]; sc[i] = siluf(v); }
    __syncthreads();
    for (int task = blockIdx.x; task < 288; task += gridDim.x) {
        const int l = task / 144, cgp = task % 144;
        const float* w = c.in(I_WMOD) + (size_t)l * 1024 * 9216 + cgp * 64 + c.lane;
        float acc[17];
#pragma unroll
        for (int b = 0; b < 17; ++b) acc[b] = 0.f;
#pragma unroll 8
        for (int kk = 0; kk < 128; ++kk) {
            const int k = c.wave * 128 + kk; const float wv = w[(size_t)k * 9216];
#pragma unroll
            for (int b = 0; b < 17; ++b) acc[b] += sc[b * 1024 + k] * wv;
        }
#pragma unroll
        for (int b = 0; b < 17; ++b) red[(c.wave * 17 + b) * 64 + c.lane] = acc[b];
        __syncthreads();
        for (int o = c.tid; o < 17 * 64; o += NTHR) {
            const int b = o >> 6, ln = o & 63; float s = 0.f;
#pragma unroll
            for (int wv = 0; wv < 8; ++wv) s += red[(wv * 17 + b) * 64 + ln];
            s += c.in(I_BMOD)[l * 9216 + cgp * 64 + ln];
            c.mod[(size_t)(l * 17 + b) * 9216 + cgp * 64 + ln] = s;
        }
        __syncthreads();
    }
}

template <class F>
__device__ __forceinline__ void conv_job(const Ctx& c, bf16_t* Bt, int K, int Ndst, F src, int& rot) {
    float* tile = (float*)c.lds;
    const int nk = K / 64, nn = Ndst / 64, total = nk * nn;
    const int ln = c.tid & 63, lk = c.tid >> 6;
    const int sn = c.tid >> 3, sk = c.tid & 7;
    float r[8];
    int t = ((int)blockIdx.x + (int)gridDim.x - rot) % (int)gridDim.x;
    rot = (rot + total) % (int)gridDim.x;
    if (t < total) { const int n0 = (t / nk) * 64, k0 = (t % nk) * 64;
#pragma unroll
        for (int e = 0; e < 8; ++e) r[e] = src(n0 + ln, k0 + lk + 8 * e); }
    for (; t < total; t += gridDim.x) {
        const int n0 = (t / nk) * 64, k0 = (t % nk) * 64;
        __syncthreads();
#pragma unroll
        for (int e = 0; e < 8; ++e) tile[(lk + 8 * e) * 65 + ln] = r[e];
        __syncthreads();
        const int tn = t + gridDim.x;
        if (tn < total) { const int n1 = (tn / nk) * 64, k1 = (tn % nk) * 64;
#pragma unroll
            for (int e = 0; e < 8; ++e) r[e] = src(n1 + ln, k1 + lk + 8 * e); }
        u32x4 w;
        w.x = pk2(tile[(sk * 8 + 0) * 65 + sn], tile[(sk * 8 + 1) * 65 + sn]); w.y = pk2(tile[(sk * 8 + 2) * 65 + sn], tile[(sk * 8 + 3) * 65 + sn]);
        w.z = pk2(tile[(sk * 8 + 4) * 65 + sn], tile[(sk * 8 + 5) * 65 + sn]); w.w = pk2(tile[(sk * 8 + 6) * 65 + sn], tile[(sk * 8 + 7) * 65 + sn]);
        *(u32x4*)(Bt + (size_t)(n0 + sn) * K + k0 + sk * 8) = w;
    }
    __syncthreads();
}
__device__ __forceinline__ int win_map(int n) {
    if (n < 256) return n;
    if (n < 512) return 1456 + (n - 256);
    if (n < 768) return 1968 + (n - 512);
    if (n < 1024) return 1040 + (n - 768);
    if (n < 1152) return 1296 + (n - 1024);
    if (n < 1184) return 1424 + (n - 1152);
    if (n < 1440) return 256 + (n - 1184);
    if (n < 1696) return 512 + (n - 1440);
    if (n < 1952) return 768 + (n - 1696);
    if (n < 2080) return 1712 + (n - 1952);
    if (n < 2208) return 1840 + (n - 2080);
    if (n < 2720) return 2224 + (n - 2208);
    if (n < 2736) return 1024 + (n - 2720);
    if (n < 2744) return 2736 + (n - 2736);
    return -1;
}
__device__ __forceinline__ void conv_phase(const Ctx& c, int l) {
    unsigned char* wb = c.wb; int rot = 0;
    { const float* W = c.in(I_F1WI) + (size_t)l * 1024 * 5632;
      conv_job(c, (bf16_t*)(wb + WB_WI1), 1024, 5632, [=](int n, int k) { const int t = n >> 8, w = n & 255; const int col = w < 128 ? t * 128 + w : FF + t * 128 + (w - 128); return W[(size_t)k * 5632 + col]; }, rot); }
    { const float* W = c.in(I_F2WI) + (size_t)l * 1024 * 5632;
      conv_job(c, (bf16_t*)(wb + WB_WI2), 1024, 5632, [=](int n, int k) { const int t = n >> 8, w = n & 255; const int col = w < 128 ? t * 128 + w : FF + t * 128 + (w - 128); return W[(size_t)k * 5632 + col]; }, rot); }
    { const float* W = c.in(I_F1WO) + (size_t)l * 2816 * 1024;
      conv_job(c, (bf16_t*)(wb + WB_WO1), 2816, 1024, [=](int n, int k) { return W[(size_t)k * 1024 + n]; }, rot); }
    { const float* W = c.in(I_F2WO) + (size_t)l * 2816 * 1024;
      conv_job(c, (bf16_t*)(wb + WB_WO2), 2816, 1024, [=](int n, int k) { return W[(size_t)k * 1024 + n]; }, rot); }
    { const float* W = c.in(I_WIN) + (size_t)l * 1024 * 2744;
      conv_job(c, (bf16_t*)(wb + WB_WIN), 1024, 2816, [=](int n, int k) { const int col = win_map(n); return col >= 0 ? W[(size_t)k * 2744 + col] : 0.f; }, rot); }
    { const float* W = c.in(I_WOUT) + (size_t)l * 1024 * 1024;
      conv_job(c, (bf16_t*)(wb + WB_WOUT), 1024, 1024, [=](int n, int k) { const int ko = k < 256 ? k : (k < 512 ? k + 256 : (k < 768 ? k + 256 : k - 512)); return W[(size_t)ko * 1024 + n]; }, rot); }
    { const float* Wq = c.in(I_AWQ) + (size_t)l * 256 * 384; const float* Wkv = c.in(I_AWKV) + (size_t)l * 128 * 512;
      const float* qn = c.in(I_AQN) + l * 256; const float* kvn = c.in(I_AKVN) + l * 128;
      conv_job(c, (bf16_t*)(wb + WB_MLA), 384, 1024, [=](int n, int k) {
          if (n < 384) return k < 256 ? qn[k] * Wq[(size_t)k * 384 + n] : 0.f;
          if (n < 896) return k >= 256 ? kvn[k - 256] * Wkv[(size_t)(k - 256) * 512 + (n - 384)] : 0.f;
          return 0.f; }, rot); }
}

__device__ __forceinline__ void norm_phase(const Ctx& c, const float* srcl, const float* srcc, int nrows, const float* gain, const float* mod, int ish, int isc) {
    const int half = nrows >> 1;
    const int step = gridDim.x * 8;
    int row = blockIdx.x * 8 + c.wave;
    f32x4 v[2][4], vn[2][4];
    auto rowptr = [&](int r) { return r < RL ? srcl + (size_t)r * 1024 : srcc + (size_t)(r - RL) * 1024; };
    if (row < half) {
#pragma unroll
        for (int q = 0; q < 2; ++q) { const float* h = rowptr(row + q * half);
#pragma unroll
            for (int i = 0; i < 4; ++i) v[q][i] = *(const f32x4*)(h + i * 256 + c.lane * 4); }
    }
    for (; row < half; row += step) {
        const bool more = row + step < half;
        if (more) {
#pragma unroll
            for (int q = 0; q < 2; ++q) { const float* h = rowptr(row + step + q * half);
#pragma unroll
                for (int i = 0; i < 4; ++i) vn[q][i] = *(const f32x4*)(h + i * 256 + c.lane * 4); }
        }
        float ss[2];
#pragma unroll
        for (int q = 0; q < 2; ++q) { ss[q] = 0.f;
#pragma unroll
            for (int i = 0; i < 4; ++i) ss[q] += v[q][i][0] * v[q][i][0] + v[q][i][1] * v[q][i][1] + v[q][i][2] * v[q][i][2] + v[q][i][3] * v[q][i][3]; }
        ss[0] = wave_sum(ss[0]); ss[1] = wave_sum(ss[1]);
#pragma unroll
        for (int q = 0; q < 2; ++q) {
            const int r = row + q * half; const int bi = r < RL ? (r >> 11) : 16;
            const float* shp = mod + (size_t)(bi * 9 + ish) * 1024; const float* scp = mod + (size_t)(bi * 9 + isc) * 1024;
            const float rstd = __builtin_amdgcn_rsqf(ss[q] * (1.f / 1024.f) + EPS);
#pragma unroll
            for (int i = 0; i < 4; ++i) {
                const int col = i * 256 + c.lane * 4;
                const f32x4 g = *(const f32x4*)(gain + col), s4 = *(const f32x4*)(scp + col), h4 = *(const f32x4*)(shp + col);
                const f32x4 y = (v[q][i] * rstd * g) * (s4 + 1.f) + h4;
                u32x2 w; w.x = pk2(y[0], y[1]); w.y = pk2(y[2], y[3]);
                *(u32x2*)(c.xn + (size_t)r * 1024 + col) = w;
            }
        }
        if (more) {
#pragma unroll
            for (int q = 0; q < 2; ++q)
#pragma unroll
                for (int i = 0; i < 4; ++i) v[q][i] = vn[q][i];
        }
    }
}

#if N_MIX

__device__ __forceinline__ int chunk_row(int b, int tc) { return tc < 4 ? RL + b * CL + tc * 64 : b * TL + (tc - 4) * 64; }
__device__ __forceinline__ int scan_idx(int d, int tc) { return d == 0 ? tc : (tc < 4 ? 3 - tc : 39 - tc); }
__device__ __forceinline__ float wave_incl_scan(float v, int lane) {
#pragma unroll
    for (int o = 1; o < 64; o <<= 1) { const float t = __shfl_up(v, o); if (lane >= o) v += t; }
    return v;
}
__device__ __forceinline__ void ld8(const bf16_t* p, float (&o)[8]) {
    const u32x4 w = *(const u32x4*)p;
    o[0] = __uint_as_float(w.x << 16); o[1] = __uint_as_float(w.x & 0xffff0000u); o[2] = __uint_as_float(w.y << 16); o[3] = __uint_as_float(w.y & 0xffff0000u);
    o[4] = __uint_as_float(w.z << 16); o[5] = __uint_as_float(w.z & 0xffff0000u); o[6] = __uint_as_float(w.w << 16); o[7] = __uint_as_float(w.w & 0xffff0000u);
}
__device__ __forceinline__ void st8(bf16_t* p, const float (&v)[8]) {
    u32x4 w; w.x = pk2(v[0], v[1]); w.y = pk2(v[2], v[3]); w.z = pk2(v[4], v[5]); w.w = pk2(v[6], v[7]); *(u32x4*)p = w;
}

__device__ __forceinline__ void swa_prep(const Ctx& c, int l, int b, int tc) {
    bf16_t* vs = (bf16_t*)c.lds;
    const int rowbase = chunk_row(b, tc); const bool lat = tc >= 4;
    bf16_t* Ksw = (bf16_t*)(c.ws() + WS_KS); bf16_t* Vts = (bf16_t*)(c.ws() + WS_VTS);
    const float qg = c.in(I_SQG)[l * 64 + c.lane], kg = c.in(I_SKG)[l * 64 + c.lane];
    const int a = c.lane >> 5, pp = (c.lane >> 4) & 1, f = c.lane & 15;
    const float inv = __expf(-(float)f * (1.f / 16.f) * 9.210340372f);
    __syncthreads();
#pragma unroll 1
    for (int r = 0; r < 4; ++r) {
        int jj[2]; bf16_t* up[2]; bf16_t qraw[2][4], kraw[2][2], vraw[2][2];
#pragma unroll
        for (int q = 0; q < 2; ++q) {
            jj[q] = c.wave * 8 + r + q * 4; up[q] = c.U + (size_t)(rowbase + jj[q]) * UC;
#pragma unroll
            for (int h = 0; h < 4; ++h) qraw[q][h] = up[q][UC_WQ + h * 64 + c.lane];
#pragma unroll
            for (int kv = 0; kv < 2; ++kv) { kraw[q][kv] = up[q][UC_WK + kv * 64 + c.lane]; vraw[q][kv] = up[q][UC_WV + kv * 64 + c.lane]; }
        }
#pragma unroll
        for (int q = 0; q < 2; ++q) {
            const int j = jj[q];
            float cs = 1.f, sn = 0.f;
            if (lat) { const float ang = (float)(a ? j : (tc - 4)) * inv; sn = __sinf(ang); cs = __cosf(ang); }
            bf16_t qo[4], ko[2];
#pragma unroll
            for (int h = 0; h < 4; ++h) {
                const float x = bf2f(qraw[q][h]);
                const float ms = wave_sum(x * x) * (1.f / 64.f);
                float y = x * __builtin_amdgcn_rsqf(ms + EPS) * qg;
                const float pr = __shfl_xor(y, 16);
                y = pp == 0 ? y * cs - pr * sn : y * cs + pr * sn;
                qo[h] = f2bf(y);
            }
#pragma unroll
            for (int kv = 0; kv < 2; ++kv) {
                const float x = bf2f(kraw[q][kv]);
                const float ms = wave_sum(x * x) * (1.f / 64.f);
                float y = x * __builtin_amdgcn_rsqf(ms + EPS) * kg;
                const float pr = __shfl_xor(y, 16);
                y = pp == 0 ? y * cs - pr * sn : y * cs + pr * sn;
                ko[kv] = f2bf(y);
                vs[j * 128 + kv * 64 + c.lane] = vraw[q][kv];
            }
#pragma unroll
            for (int h = 0; h < 4; ++h) up[q][UC_WQ + h * 64 + c.lane] = qo[h];
#pragma unroll
            for (int kv = 0; kv < 2; ++kv) Ksw[((size_t)(b * 2 + kv) * KEYS + tc * 64 + j) * 64 + c.lane] = ko[kv];
        }
    }
    __syncthreads();
    { const int kd = c.tid >> 2, jq = c.tid & 3;
      bf16_t* dst = Vts + ((size_t)(b * 2 + (kd >> 6)) * 64 + (kd & 63)) * KEYS + tc * 64 + jq * 16;
      unsigned w[8];
#pragma unroll
      for (int i = 0; i < 8; ++i) w[i] = (unsigned)vs[(jq * 16 + 2 * i) * 128 + kd] | ((unsigned)vs[(jq * 16 + 2 * i + 1) * 128 + kd] << 16);
      *(u32x4*)dst = (u32x4){w[0], w[1], w[2], w[3]}; *(u32x4*)(dst + 8) = (u32x4){w[4], w[5], w[6], w[7]}; }
}

__device__ __forceinline__ void mm64(const bf16_t* A, const bf16_t* Bt, int wave, int fr, int fq, f32x4 (&acc)[2]) {
    const bf16_t* ap = A + ((wave >> 1) * 16 + fr) * 72 + fq * 8; const bf16_t* bp = Bt + ((wave & 1) * 32 + fr) * 72 + fq * 8;
#pragma unroll
    for (int kc = 0; kc < 2; ++kc) { const bf16x8 av = *(const bf16x8*)(ap + kc * 32);
#pragma unroll
        for (int ct = 0; ct < 2; ++ct) { const bf16x8 bv = *(const bf16x8*)(bp + ct * 16 * 72 + kc * 32); acc[ct] = __builtin_amdgcn_mfma_f32_16x16x32_bf16(av, bv, acc[ct], 0, 0, 0); } }
}

__device__ __forceinline__ void mlstm_local(const Ctx& c, int l, int b, int hh, int tc) {
    bf16_t* Vt = (bf16_t*)c.lds; bf16_t* Kf = Vt + 64 * 72; bf16_t* Kb = Kf + 64 * 72; float* wf = (float*)(Kb + 64 * 72); float* wb = wf + 64;
    const int rowbase = chunk_row(b, tc);
    bf16_t* STM = (bf16_t*)(c.ws() + WS_STM); float* DECM = (float*)(c.ws() + WS_DECM);
    const int fr = c.lane & 15, fq = c.lane >> 4, rt = (c.wave >> 1) * 16 + fq * 4, cb = (c.wave & 1) * 32 + fr;
    __syncthreads();
    float k8[8], v8[8];
    { const int j = c.tid >> 3, cg8 = c.tid & 7; const bf16_t* up = c.U + (size_t)(rowbase + j) * UC + hh * 64 + cg8 * 8; ld8(up + UC_MK, k8); ld8(up + UC_MV, v8); }
    if (c.wave == 0) {
        const float* gp = c.gates + (size_t)(rowbase + c.lane) * 32; const float* gb = c.in(I_MGB) + l * 16;
        const float i_f = gp[hh] + gb[hh], f_f = logsigf(gp[4 + hh] + gb[4 + hh]), i_b = gp[8 + hh] + gb[8 + hh], f_b = logsigf(gp[12 + hh] + gb[12 + hh]);
        const float cf = wave_incl_scan(f_f, c.lane), cbk = wave_incl_scan(f_b, c.lane);
        const float totf = __shfl(cf, 63), totb = __shfl(cbk, 63);
        wf[c.lane] = __expf(i_f + totf - cf) * 0.125f;
        wb[c.lane] = __expf(i_b + cbk - f_b) * 0.125f;
        if (c.lane == 0) { DECM[((b * 4 + hh) * 2 + 0) * NCH + scan_idx(0, tc)] = __expf(totf); DECM[((b * 4 + hh) * 2 + 1) * NCH + scan_idx(1, tc)] = __expf(totb); }
    }
    __syncthreads();
    { const int j = c.tid >> 3, cg8 = c.tid & 7; const float a = wf[j], bb = wb[j];
#pragma unroll
      for (int i = 0; i < 8; ++i) { Vt[(cg8 * 8 + i) * 72 + j] = f2bf(v8[i]); Kf[(cg8 * 8 + i) * 72 + j] = f2bf(k8[i] * a); Kb[(cg8 * 8 + i) * 72 + j] = f2bf(k8[i] * bb); } }
    __syncthreads();
    bf16_t* s0 = STM + ((size_t)((b * 4 + hh) * 2 + 0) * NCH + scan_idx(0, tc)) * 4160;
    bf16_t* s1 = STM + ((size_t)((b * 4 + hh) * 2 + 1) * NCH + scan_idx(1, tc)) * 4160;
    { f32x4 af[2], ab[2]; af[0] = (f32x4){0.f, 0.f, 0.f, 0.f}; af[1] = af[0]; ab[0] = af[0]; ab[1] = af[0];
      mm64(Vt, Kf, c.wave, fr, fq, af); mm64(Vt, Kb, c.wave, fr, fq, ab);
#pragma unroll
      for (int j = 0; j < 4; ++j) { s0[(rt + j) * 64 + cb] = f2bf(af[0][j]); s0[(rt + j) * 64 + cb + 16] = f2bf(af[1][j]); s1[(rt + j) * 64 + cb] = f2bf(ab[0][j]); s1[(rt + j) * 64 + cb + 16] = f2bf(ab[1][j]); } }
    { const int dk = c.tid >> 3, jg = c.tid & 7; float f8[8], b8[8]; ld8(Kf + dk * 72 + jg * 8, f8); ld8(Kb + dk * 72 + jg * 8, b8);
      float nf = 0.f, nb = 0.f;
#pragma unroll
      for (int i = 0; i < 8; ++i) { nf += f8[i]; nb += b8[i]; }
      nf += __shfl_xor(nf, 1); nf += __shfl_xor(nf, 2); nf += __shfl_xor(nf, 4); nb += __shfl_xor(nb, 1); nb += __shfl_xor(nb, 2); nb += __shfl_xor(nb, 4);
      if (jg == 0) { s0[4096 + dk] = f2bf(nf); s1[4096 + dk] = f2bf(nb); } }
}

__device__ __forceinline__ int ssd_gch(int grp, int lc) { return lc < 128 ? grp * 128 + lc : (lc < 192 ? 256 + grp * 64 + (lc - 128) : 384 + grp * 64 + (lc - 192)); }
template <bool WANT_C>
__device__ __forceinline__ void ssd_conv(const Ctx& c, int l, int b, int grp, int tc, bf16_t* xin, float* xc, float* Bd, int bstride_n, int bstride_s, float* Cc) {
    const int rowbase = chunk_row(b, tc); const int lcn = tc < 4 ? tc : tc - 4, nchk = tc < 4 ? 4 : 32;
    for (int idx = c.tid; idx < 68 * 32; idx += NTHR) {
        const int rr = idx >> 5, ch8 = idx & 31, lc = ch8 * 8;
        const int trel = rr - 2; const bool ok = !((lcn == 0 && trel < 0) || (lcn == nchk - 1 && trel >= 64));
        u32x4 w = (u32x4){0u, 0u, 0u, 0u};
        if (ok) w = *(const u32x4*)(c.U + (size_t)(rowbase + trel) * UC + UC_XBC + ssd_gch(grp, lc));
        *(u32x4*)(xin + rr * 256 + lc) = w;
    }
    __syncthreads();
    { const int lc = c.tid & 255, jh = c.tid >> 8, gch = ssd_gch(grp, lc);
      const float* cw = c.in(I_CW) + (size_t)l * 5 * 512 + gch; const float w0 = cw[0], w1 = cw[512], w2 = cw[1024], w3 = cw[1536], w4 = cw[2048], bias = c.in(I_CB)[l * 512 + gch];
      if (WANT_C || lc < 192) {
#pragma unroll 2
        for (int j = jh * 32; j < jh * 32 + 32; ++j) {
            const float y = bias + w0 * bf2f(xin[j * 256 + lc]) + w1 * bf2f(xin[(j + 1) * 256 + lc]) + w2 * bf2f(xin[(j + 2) * 256 + lc]) + w3 * bf2f(xin[(j + 3) * 256 + lc]) + w4 * bf2f(xin[(j + 4) * 256 + lc]);
            const float v = siluf(y);
            if (lc < 128) xc[j * 128 + lc] = v; else if (lc < 192) Bd[(lc - 128) * bstride_n + j * bstride_s] = v; else if (WANT_C) Cc[j * 65 + (lc - 192)] = v;
        }
      } }
}
__device__ __forceinline__ void ssd_gate(const Ctx& c, int l, int row, int h, int d, float& a, float& dt, float& pf, float& tot) {
    dt = softplusf(c.gates[(size_t)row * 32 + 16 + d * 4 + h] + c.in(I_DTB)[l * 8 + d * 4 + h]);
    a = -__expf(c.in(I_ALOG)[l * 8 + d * 4 + h]) * dt;
    pf = wave_incl_scan(a, c.lane); tot = __shfl(pf, 63);
}
__device__ __forceinline__ void ssd_local(const Ctx& c, int l, int b, int grp, int tc) {
    bf16_t* xin = (bf16_t*)c.lds; bf16_t* Xt = (bf16_t*)(c.lds + 68 * 256 * 2); bf16_t* Bw = Xt + 128 * 72; float* wd = (float*)(Bw + 4 * 64 * 72);
    bf16_t* STS = (bf16_t*)(c.ws() + WS_STS); float* DECS = (float*)(c.ws() + WS_DECS);
    const int rowbase = chunk_row(b, tc); const int lcn = tc < 4 ? tc : tc - 4, nchk = tc < 4 ? 4 : 32;
    const int fr = c.lane & 15, fq = c.lane >> 4, rt = (c.wave >> 1) * 16 + fq * 4, cb = (c.wave & 1) * 32 + fr;
    __syncthreads();
    for (int idx = c.tid; idx < 68 * 24; idx += NTHR) {
        const int rr = idx / 24, lc = (idx % 24) * 8, trel = rr - 2; const bool ok = !((lcn == 0 && trel < 0) || (lcn == nchk - 1 && trel >= 64));
        u32x4 w = (u32x4){0u, 0u, 0u, 0u};
        if (ok) w = *(const u32x4*)(c.U + (size_t)(rowbase + trel) * UC + UC_XBC + ssd_gch(grp, lc));
        *(u32x4*)(xin + rr * 256 + lc) = w;
    }
    if (c.wave < 4) {
        const int hl = c.wave >> 1, d = c.wave & 1, h = grp * 2 + hl; float a, dt, pf, tot;
        ssd_gate(c, l, rowbase + c.lane, h, d, a, dt, pf, tot);
        wd[c.wave * 64 + c.lane] = (d == 0 ? __expf(tot - pf) : __expf(pf - a)) * dt;
        if (c.lane == 0) DECS[((b * 4 + h) * 2 + d) * NCH + scan_idx(d, tc)] = __expf(tot);
    }
    __syncthreads();
    if (c.tid < 384) { const int lc = c.tid % 192, jh = c.tid / 192, gch = ssd_gch(grp, lc);
      const float* cw = c.in(I_CW) + (size_t)l * 5 * 512 + gch; const float w0 = cw[0], w1 = cw[512], w2 = cw[1024], w3 = cw[1536], w4 = cw[2048], bias = c.in(I_CB)[l * 512 + gch];
#pragma unroll 2
      for (int j = jh * 32; j < jh * 32 + 32; ++j) {
          const float y = bias + w0 * bf2f(xin[j * 256 + lc]) + w1 * bf2f(xin[(j + 1) * 256 + lc]) + w2 * bf2f(xin[(j + 2) * 256 + lc]) + w3 * bf2f(xin[(j + 3) * 256 + lc]) + w4 * bf2f(xin[(j + 4) * 256 + lc]);
          const float v = siluf(y);
          if (lc < 128) Xt[lc * 72 + j] = f2bf(v);
          else {
#pragma unroll
              for (int q = 0; q < 4; ++q) Bw[(q * 64 + (lc - 128)) * 72 + j] = f2bf(v * wd[q * 64 + j]); }
      } }
    __syncthreads();
#pragma unroll 1
    for (int q = 0; q < 4; ++q) {
        f32x4 sa[2]; sa[0] = (f32x4){0.f, 0.f, 0.f, 0.f}; sa[1] = sa[0];
        mm64(Xt + (q >> 1) * 64 * 72, Bw + q * 64 * 72, c.wave, fr, fq, sa);
        bf16_t* sp = STS + ((size_t)((b * 4 + grp * 2 + (q >> 1)) * 2 + (q & 1)) * NCH + scan_idx(q & 1, tc)) * 4096;
#pragma unroll
        for (int j = 0; j < 4; ++j) { sp[(rt + j) * 64 + cb] = f2bf(sa[0][j]); sp[(rt + j) * 64 + cb + 16] = f2bf(sa[1][j]); }
    }
}

__device__ __forceinline__ void scan_vec8(bf16_t* base, int per_elems, const float* dec) {
    float cs[8];
#pragma unroll
    for (int i = 0; i < 8; ++i) cs[i] = 0.f;
#pragma unroll 1
    for (int k0 = 0; k0 < NCH; k0 += 9) {
        u32x4 w[9]; float dk[9];
#pragma unroll
        for (int k = 0; k < 9; ++k) { w[k] = *(const u32x4*)(base + (size_t)(k0 + k) * per_elems); dk[k] = dec[k0 + k]; }
#pragma unroll
        for (int k = 0; k < 9; ++k) {
            st8(base + (size_t)(k0 + k) * per_elems, cs);
            const float u8[8] = {__uint_as_float(w[k].x << 16), __uint_as_float(w[k].x & 0xffff0000u), __uint_as_float(w[k].y << 16), __uint_as_float(w[k].y & 0xffff0000u),
                                 __uint_as_float(w[k].z << 16), __uint_as_float(w[k].z & 0xffff0000u), __uint_as_float(w[k].w << 16), __uint_as_float(w[k].w & 0xffff0000u)};
#pragma unroll
            for (int i = 0; i < 8; ++i) cs[i] = dk[k] * cs[i] + u8[i];
        }
    }
}
__device__ __forceinline__ void scan_phase(const Ctx& c) {
    bf16_t* STM = (bf16_t*)(c.ws() + WS_STM); bf16_t* STS = (bf16_t*)(c.ws() + WS_STS); const float* DM = (const float*)(c.ws() + WS_DECM); const float* DS = (const float*)(c.ws() + WS_DECS);
    constexpr int NV = 128 * 512;
    for (int it = blockIdx.x * NTHR + c.tid; it < 2 * NV; it += gridDim.x * NTHR) {
        const bool isM = it < NV; const int u = isM ? it : it - NV, chain = u >> 9, v = u & 511;
        if (isM) scan_vec8(STM + (size_t)chain * NCH * 4160 + v * 8, 4160, DM + chain * NCH);
        else scan_vec8(STS + (size_t)chain * NCH * 4096 + v * 8, 4096, DS + chain * NCH);
    }
    for (int it = ((int)gridDim.x - 1 - (int)blockIdx.x) * NTHR + c.tid; it < 128 * 8; it += gridDim.x * NTHR) {
        const int chain = it >> 3, v = it & 7;
        scan_vec8(STM + (size_t)chain * NCH * 4160 + 4096 + v * 8, 4160, DM + chain * NCH);
    }
}

__device__ __forceinline__ void mla_finish(const Ctx& c, int l, int b, int tc) {
    bf16_t* vs = (bf16_t*)c.lds;
    const int rowbase = chunk_row(b, tc); const bool lat = tc >= 4;
    bf16_t* QM = (bf16_t*)(c.ws() + WS_QM); bf16_t* KM = (bf16_t*)(c.ws() + WS_KM); bf16_t* VTM = (bf16_t*)(c.ws() + WS_VTM);
    const bf16_t* QKV = c.xn;
    const float qgn = c.in(I_AQG)[l * 96 + c.lane], kgn = c.in(I_AKG)[l * 96 + c.lane];
    const float qgr = c.lane < 32 ? c.in(I_AQG)[l * 96 + 64 + c.lane] : 0.f, kgr = c.lane < 32 ? c.in(I_AKG)[l * 96 + 64 + c.lane] : 0.f;
    const int a = (c.lane >> 4) & 1, pp = (c.lane >> 3) & 1, f = c.lane & 7;
    const float inv = __expf(-(float)f * (1.f / 8.f) * 9.210340372f);
    __syncthreads();
#pragma unroll 1
    for (int r = 0; r < 4; ++r) {
        int jj[2], pos[2]; const bf16_t* up[2]; const bf16_t* rp[2];
        u32x2 waq[2]; unsigned wakv[2]; bf16_t krr[2], rqn[2][4], rqr[2][4], rkn[2][4], rvv[2][4];
#pragma unroll
        for (int q = 0; q < 2; ++q) {
            jj[q] = c.wave * 8 + r + q * 4; const int row = rowbase + jj[q]; pos[q] = tc * 64 + jj[q];
            up[q] = c.U + (size_t)row * UC; rp[q] = QKV + (size_t)row * 1024;
            waq[q] = *(const u32x2*)(up[q] + UC_AQ + c.lane * 4); wakv[q] = *(const unsigned*)(up[q] + UC_AKV + c.lane * 2);
            krr[q] = c.lane < 32 ? up[q][UC_AKR + c.lane] : (bf16_t)0;
#pragma unroll
            for (int h = 0; h < 4; ++h) { rqn[q][h] = rp[q][h * 96 + c.lane]; rqr[q][h] = c.lane < 32 ? rp[q][h * 96 + 64 + c.lane] : (bf16_t)0; rkn[q][h] = rp[q][384 + h * 128 + c.lane]; rvv[q][h] = rp[q][384 + h * 128 + 64 + c.lane]; }
        }
#pragma unroll
        for (int q = 0; q < 2; ++q) {
            const int j = jj[q];
            float cs = 1.f, sn = 0.f;
            if (lat) { const float ang = (float)(a ? j : (tc - 4)) * inv; sn = __sinf(ang); cs = __cosf(ang); }
            float ss;
            { const float x0 = __uint_as_float(waq[q].x << 16), x1 = __uint_as_float(waq[q].x & 0xffff0000u), x2 = __uint_as_float(waq[q].y << 16), x3 = __uint_as_float(waq[q].y & 0xffff0000u);
              ss = wave_sum(x0 * x0 + x1 * x1 + x2 * x2 + x3 * x3); }
            const float rq = __builtin_amdgcn_rsqf(ss * (1.f / 256.f) + EPS);
            { const float x0 = __uint_as_float(wakv[q] << 16), x1 = __uint_as_float(wakv[q] & 0xffff0000u); ss = wave_sum(x0 * x0 + x1 * x1); }
            const float rkv = __builtin_amdgcn_rsqf(ss * (1.f / 128.f) + EPS);
            bf16_t oqn[4], oqr[4], okn[4];
#pragma unroll
            for (int h = 0; h < 4; ++h) {
                { const float x = bf2f(rqn[q][h]) * rq; const float ms = wave_sum(x * x) * (1.f / 64.f); oqn[h] = f2bf(x * __builtin_amdgcn_rsqf(ms + EPS) * qgn); }
                { const float x = bf2f(rqr[q][h]) * rq; const float ms = wave_sum(x * x) * (1.f / 32.f);
                  float y = x * __builtin_amdgcn_rsqf(ms + EPS) * qgr; const float pr = __shfl_xor(y, 8); y = pp == 0 ? y * cs - pr * sn : y * cs + pr * sn; oqr[h] = f2bf(y); }
                { const float x = bf2f(rkn[q][h]) * rkv; const float ms = wave_sum(x * x) * (1.f / 64.f); okn[h] = f2bf(x * __builtin_amdgcn_rsqf(ms + EPS) * kgn); }
                vs[j * 256 + h * 64 + c.lane] = f2bf(bf2f(rvv[q][h]) * rkv);
            }
            bf16_t okr;
            { const float x = bf2f(krr[q]); const float ms = wave_sum(x * x) * (1.f / 32.f);
              float y = x * __builtin_amdgcn_rsqf(ms + EPS) * kgr; const float pr = __shfl_xor(y, 8); y = pp == 0 ? y * cs - pr * sn : y * cs + pr * sn; okr = f2bf(y); }
#pragma unroll
            for (int h = 0; h < 4; ++h) {
                const size_t qo = ((size_t)(b * 4 + h) * KEYS + pos[q]) * 96;
                QM[qo + c.lane] = oqn[h]; KM[qo + c.lane] = okn[h];
                if (c.lane < 32) { QM[qo + 64 + c.lane] = oqr[h]; KM[qo + 64 + c.lane] = okr; }
            }
        }
    }
    __syncthreads();
    { const int hd = c.tid >> 1, jh = c.tid & 1;
      bf16_t* dst = VTM + ((size_t)(b * 4 + (hd >> 6)) * 64 + (hd & 63)) * KEYS + tc * 64 + jh * 32;
#pragma unroll
      for (int q = 0; q < 4; ++q) { unsigned w[4];
#pragma unroll
          for (int i = 0; i < 4; ++i) w[i] = (unsigned)vs[(jh * 32 + q * 8 + 2 * i) * 256 + hd] | ((unsigned)vs[(jh * 32 + q * 8 + 2 * i + 1) * 256 + hd] << 16);
          *(u32x4*)(dst + q * 8) = (u32x4){w[0], w[1], w[2], w[3]}; } }
}

typedef short bf16x4 __attribute__((ext_vector_type(4)));
template <int DQ>
__device__ __forceinline__ void attn_task(const Ctx& c, const bf16_t* Qp, int qstride, const bf16_t* Kb, const bf16_t* Vtb, int nloc, int loc0, bool masked, int tq0,
                                          float scale, float sink, bool has_sink, bf16_t* Op, int ostride) {
    constexpr int KS = DQ + 8, KCH = DQ / 8;
    constexpr float L2E = 1.44269504089f;
    bf16_t* Ks = (bf16_t*)c.lds; bf16_t* Vs = Ks + 2 * 64 * KS;
    const int fr = c.lane & 15, fq = c.lane >> 4;
    const float sc2 = scale * L2E;
    bf16x8 qa[2][DQ / 32];
#pragma unroll
    for (int g = 0; g < 2; ++g) { const bf16_t* qrow = Qp + (size_t)(c.wave * 32 + g * 16 + fr) * qstride;
#pragma unroll
      for (int kc = 0; kc < DQ / 32; ++kc) qa[g][kc] = *(const bf16x8*)(qrow + kc * 32 + fq * 8); }
    f32x4 o[2][4]; float m[2], ls[2];
#pragma unroll
    for (int g = 0; g < 2; ++g) { m[g] = has_sink ? sink * L2E : -1e30f; ls[g] = (has_sink && fq == 0) ? 1.f : 0.f;
#pragma unroll
        for (int i = 0; i < 4; ++i) o[g][i] = (f32x4){0.f, 0.f, 0.f, 0.f}; }
    const int ntiles = 4 + nloc;
    const int kr0 = c.tid / KCH, kc0 = c.tid % KCH, kr1 = (c.tid + NTHR) / KCH, kc1 = (c.tid + NTHR) % KCH; const bool k2 = (DQ == 96) && (c.tid < 64 * KCH - NTHR);
    const int vr = c.tid >> 3, vc = c.tid & 7;
    u32x4 rk0, rk1 = (u32x4){0u, 0u, 0u, 0u}, rv;
    { const int tile = 0;
      rk0 = *(const u32x4*)(Kb + (size_t)(tile * 64 + kr0) * DQ + kc0 * 8); if (k2) rk1 = *(const u32x4*)(Kb + (size_t)(tile * 64 + kr1) * DQ + kc1 * 8);
      rv = *(const u32x4*)(Vtb + (size_t)vr * KEYS + tile * 64 + vc * 8); }
    __syncthreads();
#pragma unroll 1
    for (int it = 0; it < ntiles; ++it) {
        const int tile = it < 4 ? it : loc0 + (it - 4);
        bf16_t* Kc = Ks + (it & 1) * 64 * KS; bf16_t* Vc = Vs + (it & 1) * 64 * 72;
        *(u32x4*)(Kc + kr0 * KS + kc0 * 8) = rk0; if (k2) *(u32x4*)(Kc + kr1 * KS + kc1 * 8) = rk1;
        *(u32x4*)(Vc + vr * 72 + vc * 8) = rv;
        __syncthreads();
        if (it + 1 < ntiles) { const int tn = (it + 1) < 4 ? (it + 1) : loc0 + (it + 1 - 4);
            rk0 = *(const u32x4*)(Kb + (size_t)(tn * 64 + kr0) * DQ + kc0 * 8); if (k2) rk1 = *(const u32x4*)(Kb + (size_t)(tn * 64 + kr1) * DQ + kc1 * 8);
            rv = *(const u32x4*)(Vtb + (size_t)vr * KEYS + tn * 64 + vc * 8); }
        f32x4 s[2][4];
#pragma unroll
        for (int nt = 0; nt < 4; ++nt) { s[0][nt] = (f32x4){0.f, 0.f, 0.f, 0.f}; s[1][nt] = s[0][nt];
#pragma unroll
            for (int kc = 0; kc < DQ / 32; ++kc) { const bf16x8 kb = *(const bf16x8*)(Kc + (nt * 16 + fr) * KS + kc * 32 + fq * 8);
                s[0][nt] = __builtin_amdgcn_mfma_f32_16x16x32_bf16(kb, qa[0][kc], s[0][nt], 0, 0, 0); s[1][nt] = __builtin_amdgcn_mfma_f32_16x16x32_bf16(kb, qa[1][kc], s[1][nt], 0, 0, 0); } }
        const bool mk = masked && it >= 4;
        bf16x8 pb[2][2];
#pragma unroll
        for (int g = 0; g < 2; ++g) {
            float mx = -1e30f;
            const int tq = tq0 + c.wave * 32 + g * 16 + fr;
#pragma unroll
            for (int nt = 0; nt < 4; ++nt)
#pragma unroll
                for (int j = 0; j < 4; ++j) { float v = s[g][nt][j] * sc2;
                    if (mk) { const int dd = tq - ((tile - 4) * 64 + nt * 16 + fq * 4 + j); if (dd > 128 || dd < -128) v = -1e30f; }
                    s[g][nt][j] = v; mx = fmaxf(mx, v); }
            mx = fmaxf(mx, __shfl_xor(mx, 16)); mx = fmaxf(mx, __shfl_xor(mx, 32));
            const float mn = fmaxf(m[g], mx), al = __builtin_amdgcn_exp2f(m[g] - mn); m[g] = mn;
            float rs = 0.f;
#pragma unroll
            for (int nt = 0; nt < 4; ++nt)
#pragma unroll
                for (int j = 0; j < 4; ++j) { const float pv = __builtin_amdgcn_exp2f(s[g][nt][j] - mn); s[g][nt][j] = pv; rs += pv; }
            ls[g] = ls[g] * al + rs;
#pragma unroll
            for (int dv = 0; dv < 4; ++dv) o[g][dv] *= al;
#pragma unroll
            for (int kc = 0; kc < 2; ++kc) { u32x4 w; w.x = pk2(s[g][2 * kc][0], s[g][2 * kc][1]); w.y = pk2(s[g][2 * kc][2], s[g][2 * kc][3]);
                w.z = pk2(s[g][2 * kc + 1][0], s[g][2 * kc + 1][1]); w.w = pk2(s[g][2 * kc + 1][2], s[g][2 * kc + 1][3]); pb[g][kc] = __builtin_bit_cast(bf16x8, w); }
        }
#pragma unroll
        for (int kc = 0; kc < 2; ++kc)
#pragma unroll
            for (int dv = 0; dv < 4; ++dv) {
                const bf16_t* vp = Vc + (dv * 16 + fr) * 72 + kc * 32 + fq * 4;
                const bf16x4 v0 = *(const bf16x4*)vp, v1 = *(const bf16x4*)(vp + 16);
                const bf16x8 va = __builtin_shufflevector(v0, v1, 0, 1, 2, 3, 4, 5, 6, 7);
                o[0][dv] = __builtin_amdgcn_mfma_f32_16x16x32_bf16(va, pb[0][kc], o[0][dv], 0, 0, 0); o[1][dv] = __builtin_amdgcn_mfma_f32_16x16x32_bf16(va, pb[1][kc], o[1][dv], 0, 0, 0); }
    }
#pragma unroll
    for (int g = 0; g < 2; ++g) {
        float lt = ls[g]; lt += __shfl_xor(lt, 16); lt += __shfl_xor(lt, 32);
        const float il = __builtin_amdgcn_rcpf(lt);
        bf16_t* orow = Op + (size_t)(c.wave * 32 + g * 16 + fr) * ostride + fq * 4;
#pragma unroll
        for (int dv = 0; dv < 4; ++dv) { u32x2 w; w.x = pk2(o[g][dv][0] * il, o[g][dv][1] * il); w.y = pk2(o[g][dv][2] * il, o[g][dv][3] * il); *(u32x2*)(orow + dv * 16) = w; }
    }
}

__device__ __forceinline__ void mlstm_out(const Ctx& c, int l, int b, int hh, int tc) {
    bf16_t* Qs = (bf16_t*)c.lds; bf16_t* Kn = Qs + 64 * 72; bf16_t* Vt = Kn + 64 * 72; bf16_t* Ct = Vt + 64 * 72; bf16_t* Ss = Ct + 64 * 72;
    float* hbuf = (float*)(Ss + 64 * 72); float* nv = hbuf + 64 * 65; float* bcum = nv + 64; float* ig = bcum + 64; float* qn = ig + 64; float* denp = qn + 64;
    const int rowbase = chunk_row(b, tc);
    const bf16_t* STM = (const bf16_t*)(c.ws() + WS_STM);
    const int t = c.tid >> 3, eg = c.tid & 7, fr = c.lane & 15, fq = c.lane >> 4;
    const int rt = (c.wave >> 1) * 16 + fq * 4, cb = (c.wave & 1) * 32 + fr;
    __syncthreads();
    { const bf16_t* up = c.U + (size_t)(rowbase + t) * UC + hh * 64 + eg * 8; float k8[8], v8[8];
      *(u32x4*)(Qs + t * 72 + eg * 8) = *(const u32x4*)(up + UC_MQ); ld8(up + UC_MK, k8); ld8(up + UC_MV, v8);
#pragma unroll
      for (int i = 0; i < 8; ++i) { k8[i] *= 0.125f; Vt[(eg * 8 + i) * 72 + t] = f2bf(v8[i]); }
      st8(Kn + t * 72 + eg * 8, k8); }
    f32x4 hacc[2];
    hacc[0] = (f32x4){0.f, 0.f, 0.f, 0.f}; hacc[1] = hacc[0];
    u32x4 stw[2]; bf16_t nvw[2]; float gbc[2] = {0.f, 0.f}, giv[2] = {0.f, 0.f};
#pragma unroll
    for (int d = 0; d < 2; ++d) { const bf16_t* st = STM + ((size_t)((b * 4 + hh) * 2 + d) * NCH + scan_idx(d, tc)) * 4160;
        stw[d] = *(const u32x4*)(st + t * 64 + eg * 8); nvw[d] = c.tid < 64 ? st[4096 + c.tid] : (bf16_t)0; }
    if (c.wave == 0) {
        const float* gp = c.gates + (size_t)(rowbase + c.lane) * 32; const float* gb = c.in(I_MGB) + l * 16;
#pragma unroll
        for (int d = 0; d < 2; ++d) {
            const float iv = gp[d * 8 + hh] + gb[d * 8 + hh], fv = logsigf(gp[d * 8 + 4 + hh] + gb[d * 8 + 4 + hh]);
            const float pf = wave_incl_scan(fv, c.lane), tot = __shfl(pf, 63);
            gbc[d] = d == 0 ? pf : (tot - pf + fv); giv[d] = iv; }
    }
#pragma unroll
    for (int d = 0; d < 2; ++d) {
        __syncthreads();
        if (c.wave == 0) { bcum[c.lane] = gbc[d]; ig[c.lane] = giv[d]; }
        *(u32x4*)(Ct + t * 72 + eg * 8) = stw[d];
        if (c.tid < 64) nv[c.tid] = bf2f(nvw[d]);
        __syncthreads();
        { float q8[8]; ld8(Qs + t * 72 + eg * 8, q8); float part = 0.f;
#pragma unroll
          for (int i = 0; i < 8; ++i) part += q8[i] * nv[eg * 8 + i];
          part += __shfl_xor(part, 1); part += __shfl_xor(part, 2); part += __shfl_xor(part, 4);
          if (eg == 0) qn[t] = part; }
        { f32x4 sa[2]; sa[0] = (f32x4){0.f, 0.f, 0.f, 0.f}; sa[1] = sa[0];
          mm64(Qs, Kn, c.wave, fr, fq, sa);
#pragma unroll
          for (int j = 0; j < 4; ++j) { const int tt = rt + j; const float bt = bcum[tt]; float rs = 0.f;
#pragma unroll
              for (int ct = 0; ct < 2; ++ct) { const int ss = cb + ct * 16; const bool ok = d == 0 ? (ss <= tt) : (ss >= tt);
                  const float v = ok ? sa[ct][j] * __expf(bt - bcum[ss] + ig[ss]) : 0.f; Ss[tt * 72 + ss] = f2bf(v); rs += v; }
              rs = row16_sum(rs);
              if (fr == 0) denp[tt * 2 + (c.wave & 1)] = rs; } }
        __syncthreads();
        { f32x4 na[2]; na[0] = (f32x4){0.f, 0.f, 0.f, 0.f}; na[1] = na[0];
          mm64(Qs, Ct, c.wave, fr, fq, na);
#pragma unroll
          for (int j = 0; j < 4; ++j) { const float ebt = __expf(bcum[rt + j]); na[0][j] *= ebt; na[1][j] *= ebt; }
          mm64(Ss, Vt, c.wave, fr, fq, na);
#pragma unroll
          for (int j = 0; j < 4; ++j) { const int tt = rt + j; const float den = denp[tt * 2] + denp[tt * 2 + 1] + __expf(bcum[tt]) * qn[tt];
              const float idn = __builtin_amdgcn_rcpf(fmaxf(fabsf(den), 1.f)); hacc[0][j] += na[0][j] * idn; hacc[1][j] += na[1][j] * idn; } }
    }
#pragma unroll
    for (int j = 0; j < 4; ++j) { hbuf[(rt + j) * 65 + cb] = hacc[0][j]; hbuf[(rt + j) * 65 + cb + 16] = hacc[1][j]; }
    __syncthreads();
    float h8[8]; float ss = 0.f;
#pragma unroll
    for (int i = 0; i < 8; ++i) { h8[i] = hbuf[t * 65 + eg * 8 + i]; ss += h8[i] * h8[i]; }
    ss += __shfl_xor(ss, 1); ss += __shfl_xor(ss, 2); ss += __shfl_xor(ss, 4);
    const float rs = __builtin_amdgcn_rsqf(ss * (1.f / 64.f) + EPS);
    bf16_t* up = c.U + (size_t)(rowbase + t) * UC + hh * 64 + eg * 8; float mo[8], o8[8]; ld8(up + UC_MO, mo);
    const float* on = c.in(I_MON) + l * 256 + hh * 64 + eg * 8;
#pragma unroll
    for (int i = 0; i < 8; ++i) o8[i] = sigmf(mo[i]) * (h8[i] * rs * on[i]);
    st8(up + UC_MQ, o8);
}

__device__ __forceinline__ void ssd_out(const Ctx& c, int l, int b, int grp, int tc) {
    bf16_t* xin = (bf16_t*)c.lds;
    float* ybuf = (float*)c.lds;
    bf16_t* Xt = (bf16_t*)(c.lds + 68 * 256 * 2);
    bf16_t* Bn = Xt + 128 * 72; bf16_t* Cn = Bn + 64 * 72; bf16_t* Ws = Cn + 64 * 72; bf16_t* Sp = Ws + 64 * 72;
    float* Gs = (float*)(Sp + 64 * 72);
    float* cum = Gs + 64 * 65; float* dtv = cum + 256;
    const bf16_t* STS = (const bf16_t*)(c.ws() + WS_STS);
    const int rowbase = chunk_row(b, tc); const int lcn = tc < 4 ? tc : tc - 4, nchk = tc < 4 ? 4 : 32;
    const int t = c.tid >> 3, pg = c.tid & 7, fr = c.lane & 15, fq = c.lane >> 4;
    const int rt = (c.wave >> 1) * 16 + fq * 4, cb = (c.wave & 1) * 32 + fr;
    __syncthreads();
    for (int idx = c.tid; idx < 68 * 32; idx += NTHR) {
        const int rr = idx >> 5, lc = (idx & 31) * 8, trel = rr - 2; const bool ok = !((lcn == 0 && trel < 0) || (lcn == nchk - 1 && trel >= 64));
        u32x4 w = (u32x4){0u, 0u, 0u, 0u};
        if (ok) w = *(const u32x4*)(c.U + (size_t)(rowbase + trel) * UC + UC_XBC + ssd_gch(grp, lc));
        *(u32x4*)(xin + rr * 256 + lc) = w;
    }
    if (c.wave < 4) {
        const int hl = c.wave >> 1, d = c.wave & 1, h = grp * 2 + hl; float a, dt, pf, tot;
        ssd_gate(c, l, rowbase + c.lane, h, d, a, dt, pf, tot);
        cum[c.wave * 64 + c.lane] = d == 0 ? pf : (tot - pf + a); dtv[c.wave * 64 + c.lane] = dt;
    }
    __syncthreads();
    { const int lc = c.tid & 255, jh = c.tid >> 8, gch = ssd_gch(grp, lc);
      const float* cw = c.in(I_CW) + (size_t)l * 5 * 512 + gch; const float w0 = cw[0], w1 = cw[512], w2 = cw[1024], w3 = cw[1536], w4 = cw[2048], bias = c.in(I_CB)[l * 512 + gch];
#pragma unroll 2
      for (int j = jh * 32; j < jh * 32 + 32; ++j) {
          const float y = bias + w0 * bf2f(xin[j * 256 + lc]) + w1 * bf2f(xin[(j + 1) * 256 + lc]) + w2 * bf2f(xin[(j + 2) * 256 + lc]) + w3 * bf2f(xin[(j + 3) * 256 + lc]) + w4 * bf2f(xin[(j + 4) * 256 + lc]);
          const bf16_t v = f2bf(siluf(y));
          if (lc < 128) Xt[lc * 72 + j] = v; else if (lc < 192) Bn[j * 72 + (lc - 128)] = v; else Cn[j * 72 + (lc - 192)] = v;
      } }
    __syncthreads();
    { f32x4 g[2]; g[0] = (f32x4){0.f, 0.f, 0.f, 0.f}; g[1] = g[0];
      mm64(Cn, Bn, c.wave, fr, fq, g);
#pragma unroll
      for (int j = 0; j < 4; ++j) { Gs[(rt + j) * 65 + cb] = g[0][j]; Gs[(rt + j) * 65 + cb + 16] = g[1][j]; } }
    f32x4 yacc[2][2];
#pragma unroll
    for (int q = 0; q < 2; ++q) { yacc[q][0] = (f32x4){0.f, 0.f, 0.f, 0.f}; yacc[q][1] = yacc[q][0]; }
    u32x4 stn = *(const u32x4*)(STS + ((size_t)((b * 4 + grp * 2) * 2) * NCH + scan_idx(0, tc)) * 4096 + t * 64 + pg * 8);
#pragma unroll 1
    for (int hd = 0; hd < 4; ++hd) {
        { const int hl = hd >> 1, d = hd & 1;
            __syncthreads();
            const float* cm = cum + (hl * 2 + d) * 64; const float* dv = dtv + (hl * 2 + d) * 64;
            { *(u32x4*)(Sp + t * 72 + pg * 8) = stn;
              if (hd < 3) { const int h2 = (hd + 1) >> 1, d2 = (hd + 1) & 1; stn = *(const u32x4*)(STS + ((size_t)((b * 4 + grp * 2 + h2) * 2 + d2) * NCH + scan_idx(d2, tc)) * 4096 + t * 64 + pg * 8); }
              const float ct = cm[t]; float w8[8];
#pragma unroll
              for (int i = 0; i < 8; ++i) { const int ss = pg * 8 + i; const bool ok = d == 0 ? (ss <= t) : (ss >= t);
                  w8[i] = ok ? Gs[t * 65 + ss] * __expf(ct - cm[ss]) * dv[ss] : 0.f; }
              st8(Ws + t * 72 + pg * 8, w8); }
            __syncthreads();
            f32x4 ya[2]; ya[0] = (f32x4){0.f, 0.f, 0.f, 0.f}; ya[1] = ya[0];
            mm64(Cn, Sp, c.wave, fr, fq, ya);
#pragma unroll
            for (int j = 0; j < 4; ++j) { const float ect = __expf(cm[rt + j]); ya[0][j] *= ect; ya[1][j] *= ect; }
            mm64(Ws, Xt + hl * 64 * 72, c.wave, fr, fq, ya);
            if (hl == 0) { yacc[0][0] += ya[0]; yacc[0][1] += ya[1]; } else { yacc[1][0] += ya[0]; yacc[1][1] += ya[1]; }
        }
    }
#pragma unroll
    for (int hl = 0; hl < 2; ++hl)
#pragma unroll
        for (int j = 0; j < 4; ++j) { ybuf[(rt + j) * 129 + hl * 64 + cb] = yacc[hl][0][j]; ybuf[(rt + j) * 129 + hl * 64 + cb + 16] = yacc[hl][1][j]; }
    __syncthreads();
    float ss = 0.f; float g[2][8];
#pragma unroll
    for (int hl = 0; hl < 2; ++hl) {
        const int h = grp * 2 + hl; const float dsk = c.in(I_SD)[l * 4 + h];
        float z8[8]; ld8(c.U + (size_t)(rowbase + t) * UC + UC_SZ + h * 64 + pg * 8, z8);
#pragma unroll
        for (int i = 0; i < 8; ++i) { const float yy = ybuf[t * 129 + hl * 64 + pg * 8 + i] + dsk * bf2f(Xt[(hl * 64 + pg * 8 + i) * 72 + t]); g[hl][i] = yy * siluf(z8[i]); ss += g[hl][i] * g[hl][i]; }
    }
    ss += __shfl_xor(ss, 1); ss += __shfl_xor(ss, 2); ss += __shfl_xor(ss, 4);
    const float rs = __builtin_amdgcn_rsqf(ss * (1.f / 128.f) + EPS);
#pragma unroll
    for (int hl = 0; hl < 2; ++hl) {
        const int h = grp * 2 + hl; const float* ng = c.in(I_SN) + l * 256 + h * 64 + pg * 8; float o8[8];
#pragma unroll
        for (int i = 0; i < 8; ++i) o8[i] = g[hl][i] * rs * ng[i];
        st8(c.U + (size_t)(rowbase + t) * UC + UC_SZ + h * 64 + pg * 8, o8);
    }
}

__device__ __forceinline__ void mix_x1_gemm(const Ctx& c, int l, pg8::StaticOrder& S) {
    pg8::Gemm g{c.U + UC_AQ, (const bf16_t*)(c.wb + WB_MLA), R, 1024, 384, UC};
    S.init(R, 1024, gridDim.x, blockIdx.x);
    EpiStore<1024, false> E{c.xn, nullptr}; pg8::gemm_phase<EpiStore<1024, false>, true, false>(c.ldsl, c.tid, g, S, E);
}
__device__ __forceinline__ void mix_x1(const Ctx& c0, int l) {
    constexpr int N_SWA = NB * NCH, N_ML = NB * 4 * NCH, N_SS = NB * 2 * NCH;
    for (int t = blockIdx.x; t < N_SWA + N_ML + N_SS; t += gridDim.x) {
        const Ctx c = retask(c0);
        if (t < N_ML) { const int b = t / (4 * NCH), r = t % (4 * NCH); mlstm_local(c, l, b, r / NCH, r % NCH); }
        else if (t < N_ML + N_SS) { const int u = t - N_ML, b = u / (2 * NCH), r = u % (2 * NCH); ssd_local(c, l, b, r / NCH, r % NCH); }
        else { const int u = t - N_ML - N_SS; swa_prep(c, l, u / NCH, u % NCH); }
    }
}
__device__ __forceinline__ void mix_x2(const Ctx& c, int l) {
    scan_phase(c);
    for (int t = blockIdx.x; t < NB * NCH; t += gridDim.x) { const Ctx cc = retask(c); mla_finish(cc, l, t / NCH, t % NCH); }
}
__device__ __forceinline__ void mix_x3(const Ctx& c0, int l, int part = -1) {
    const bool last = (l == 1);
    const int NL = NB * 4 * 8, NC = last ? 0 : NB * 4;
    const int tc0 = last ? 4 : 0, ntc = NCH - tc0;
    const int N_MLA = NL + NC, N_SWA = NL + NC, N_ML = NB * 4 * ntc, N_SS = NB * 2 * ntc;
    const int vcu = (gridDim.x & 7) == 0 ? (int)(blockIdx.x & 7) * (int)(gridDim.x >> 3) + (int)(blockIdx.x >> 3) : (int)blockIdx.x;
    for (int t = vcu; t < N_MLA + N_SWA + N_ML + N_SS; t += gridDim.x) {
        const Ctx c = retask(c0);
        const bf16_t* QM = (const bf16_t*)(c.ws() + WS_QM); const bf16_t* KM = (const bf16_t*)(c.ws() + WS_KM); const bf16_t* VTM = (const bf16_t*)(c.ws() + WS_VTM);
        const bf16_t* Ksw = (const bf16_t*)(c.ws() + WS_KS); const bf16_t* Vts = (const bf16_t*)(c.ws() + WS_VTS);
        if (part >= 0) { const int ty = t < N_MLA ? 0 : (t < N_MLA + N_SWA ? 1 : (t < N_MLA + N_SWA + N_SS ? 2 : 3)); if (ty != part) continue; }
        if (t < N_MLA) {
            const bool lat = t < NL; const int bh = lat ? (t >> 3) : (t - NL), qb = lat ? (t & 7) : 0, b = bh >> 2, h = bh & 3;
            const int qpos0 = lat ? 256 + qb * 256 : 0, row0 = lat ? b * TL + qb * 256 : RL + b * CL;
            attn_task<96>(c, QM + ((size_t)bh * KEYS + qpos0) * 96, 96, KM + (size_t)bh * KEYS * 96, VTM + (size_t)bh * 64 * KEYS, lat ? 32 : 0, 4, false, 0,
                          0.10206207262f, 0.f, false, c.U + (size_t)row0 * UC + UC_AQ + h * 64, UC);
        } else if (t < N_MLA + N_SWA) {
            const int u = t - N_MLA; const bool lat = u < NL; const int bh = lat ? (u >> 3) : (u - NL), qb = lat ? (u & 7) : 0, b = bh >> 2, h = bh & 3, kv = h >> 1;
            const int t0 = qb * 256, row0 = lat ? b * TL + t0 : RL + b * CL;
            int lo = 0, hi = -1; if (lat) { lo = t0 >= 128 ? (t0 - 128) / 64 : 0; hi = (t0 + 383) / 64; if (hi > 31) hi = 31; }
            bf16_t* qo = c.U + (size_t)row0 * UC + UC_WQ + h * 64;
            attn_task<64>(c, qo, UC, Ksw + (size_t)(b * 2 + kv) * KEYS * 64, Vts + (size_t)(b * 2 + kv) * 64 * KEYS, hi - lo + 1, 4 + lo, true, t0,
                          0.125f, c.in(I_SINK)[l * 4 + h], true, qo, UC);
        } else if (t < N_MLA + N_SWA + N_SS) {
            const int u = t - N_MLA - N_SWA, b = u / (2 * ntc), r = u % (2 * ntc); ssd_out(c, l, b, r / ntc, tc0 + r % ntc);
        } else {
            const int u = t - N_MLA - N_SWA - N_SS, b = u / (4 * ntc), r = u % (4 * ntc); mlstm_out(c, l, b, r / ntc, tc0 + r % ntc);
        }
    }
}

#endif

template <int L, int PT>
__device__ __forceinline__ void do_phase(Ctx& c, const int wv) {
    { int lane; asm volatile("v_mbcnt_lo_u32_b32 %0, -1, 0\n\tv_mbcnt_hi_u32_b32 %0, -1, %0" : "=v"(lane));
      c.lane = lane; c.wave = wv; c.tid = wv * 64 + lane;
      unsigned char* ws = c.ws();
      c.hc = (float*)(ws + WS_HC); c.mod = (float*)(ws + WS_MOD); c.gates = (float*)(ws + WS_GATES); c.wb = ws + WS_WB; c.xn = (bf16_t*)(ws + WS_XN); c.U = (bf16_t*)(ws + WS_U); }
    if constexpr (PT < 0) { mod_phase(c); conv_phase(c, 0); }
    else {
        constexpr int l = L, pt = PT;
        constexpr bool last = (l == 1);
        pg8::StaticOrder S;
        const float* modl = c.mod + (size_t)l * 17 * 9216;
        const float* hl = (l == 0 && pt <= 2) ? c.in(I_X) : c.out();
        const float* hcs = (l == 0 && pt <= 2) ? c.in(I_CTX) : c.hc;
        if constexpr (pt == 0) { if (l > 0) conv_phase(c, l); norm_phase(c, hl, hcs, R, c.in(I_F1N) + l * 1024, modl, 0, 1); }
        else if constexpr (pt == 3) norm_phase(c, hl, hcs, R, c.in(I_MIXN) + l * 1024, modl, 3, 4);
        else if constexpr (pt == 9) norm_phase(c, hl, hcs, last ? RL : R, c.in(I_F2N) + l * 1024, modl, 6, 7);
        else if constexpr (pt == 1 || pt == 10) {
            constexpr int M = (pt == 10 && last) ? RL : R;
            pg8::Gemm g{c.xn, (const bf16_t*)(c.wb + (pt == 1 ? WB_WI1 : WB_WI2)), M, 5632, 1024, 1024};
            S.init(M, 5632, gridDim.x, blockIdx.x);
            EpiSwiglu E{c.U}; pg8::gemm_phase(c.ldsl, c.tid, g, S, E); }
        else if constexpr (pt == 2 || pt == 11) {
            constexpr int M = (pt == 11 && last) ? RL : R;
            pg8::Gemm g{c.U, (const bf16_t*)(c.wb + (pt == 2 ? WB_WO1 : WB_WO2)), M, 1024, 2816, 2816};
            S.init(M, 1024, gridDim.x, blockIdx.x);
            EpiResid E{hl, hcs, c.out(), c.hc, modl, pt == 2 ? 2 : 8, 0.5f}; pg8::gemm_phase(c.ldsl, c.tid, g, S, E); }
        else if constexpr (pt == 4) {
            pg8::Gemm g{c.xn, (const bf16_t*)(c.wb + WB_WIN), R, 2816, 1024, 1024};
            S.init(R, 2816, gridDim.x, blockIdx.x);
            EpiStore<UC, true> E{c.U, c.gates}; pg8::gemm_phase(c.ldsl, c.tid, g, S, E); }
#if N_MIX
        else if constexpr (pt == 5) mix_x1_gemm(c, l, S);
        else if constexpr (pt == 12) mix_x1(c, l);
        else if constexpr (pt == 6) mix_x2(c, l);
        else if constexpr (pt == 7) mix_x3(c, l);
        else if constexpr (pt >= 13 && pt <= 16) mix_x3(c, l, pt - 13);
        else if constexpr (pt == 8) {
            constexpr int M = last ? RL : R;
            pg8::Gemm g{c.U, (const bf16_t*)(c.wb + WB_WOUT), M, 1024, 1024, UC};
            S.init(M, 1024, gridDim.x, blockIdx.x);
            EpiResid E{hl, hcs, c.out(), c.hc, modl, 5, 1.0f}; pg8::gemm_phase(c.ldsl, c.tid, g, S, E); }
#endif
    }
}

#define XB_TMO      128
#define XB_XCNT(j)  (256  + 64 * (j))
#define XB_XSUB(j)  (1280 + 64 * (j))
#define XB_XGEN(j)  (2304 + 64 * (j))
#define XB_TOP      3328
#define XB_TOPGEN   3392
#define XCD_BAR_WORDS 3456
#define XB_SPIN_CAP (1u << 18)
__device__ __forceinline__ unsigned xb_ld(unsigned* p)              { return __hip_atomic_load(p, __ATOMIC_RELAXED, __HIP_MEMORY_SCOPE_AGENT); }
__device__ __forceinline__ unsigned xb_add(unsigned* p, unsigned v) { return __hip_atomic_fetch_add(p, v, __ATOMIC_RELAXED, __HIP_MEMORY_SCOPE_AGENT); }
__device__ __forceinline__ unsigned xb_xcc_id() { return (unsigned)__builtin_amdgcn_s_getreg((3 << 11) | 20) & 0xFu; }
#define XB_SPIN(cond, bar) do { unsigned _sp = 0; while (cond) { __builtin_amdgcn_s_sleep(1); \
    if ((++_sp & 255u) == 0u) { if (xb_ld(&(bar)[XB_TMO])) break; if (_sp > XB_SPIN_CAP) { atomicAdd(&(bar)[XB_TMO], 1u); break; } } } } while (0)
__device__ __forceinline__ void xcd_barrier_complete(unsigned* bar, unsigned x, unsigned& nloc, unsigned& nx) {
    const unsigned G = gridDim.x * gridDim.y * gridDim.z;
    unsigned sum, cnt, mine, sp = 0u;
    for (;;) {
        sum = 0u; cnt = 0u; mine = 0u;
#pragma unroll
        for (unsigned j = 0; j < 16; ++j) { const unsigned cc = xb_ld(&bar[XB_XCNT(j)]); sum += cc; cnt += (cc > 0u) ? 1u : 0u; mine = (j == x) ? cc : mine; }
        if (sum == G) break;
        __builtin_amdgcn_s_sleep(1);
        if ((++sp & 255u) == 0u) { if (xb_ld(&bar[XB_TMO])) break; if (sp > XB_SPIN_CAP) { atomicAdd(&bar[XB_TMO], 1u); break; } }
    }
    nloc = mine > 0u ? mine : 1u; nx = cnt > 0u ? cnt : 1u;
}
__device__ __forceinline__ void xcd_barrier(unsigned* bar, const unsigned x, volatile LAS unsigned* st, const bool leader_thread) {
    asm volatile("s_waitcnt vmcnt(0)" ::: "memory");
    __syncthreads();
    if (leader_thread) {
        __builtin_amdgcn_s_waitcnt(0);
        unsigned nloc = st[0], nx = st[1];
        if (nloc == 0u) { xcd_barrier_complete(bar, x, nloc, nx); st[0] = nloc; st[1] = nx; }
        const unsigned old = xb_add(&bar[XB_XSUB(x)], 1u);
        const unsigned gen = old / nloc;
        if (old + 1u == (gen + 1u) * nloc) {
            __builtin_amdgcn_fence(__ATOMIC_RELEASE, "agent");
            asm volatile("s_waitcnt vmcnt(0)" ::: "memory");
            const unsigned og = xb_add(&bar[XB_TOP], 1u);
            const unsigned tg = og / nx;
            if (og + 1u == (tg + 1u) * nx) xb_add(&bar[XB_TOPGEN], 1u);
            else XB_SPIN(xb_ld(&bar[XB_TOPGEN]) == tg, bar);
            __builtin_amdgcn_fence(__ATOMIC_ACQUIRE, "agent");
            xb_add(&bar[XB_XGEN(x)], 1u);
            asm volatile("s_waitcnt vmcnt(0)" ::: "memory");
        } else {
            XB_SPIN(xb_ld(&bar[XB_XGEN(x)]) == gen, bar);
            __builtin_amdgcn_fence(__ATOMIC_ACQUIRE, "agent");
            asm volatile("s_waitcnt vmcnt(0)" ::: "memory");
        }
    }
    __syncthreads();
}

__global__ void __launch_bounds__(NTHR, 2) mega(Params p) {
    extern __shared__ __attribute__((aligned(16))) unsigned char smem[];
    cg::grid_group grid = cg::this_grid();
    Ctx c; c.lds = smem; c.ldsl = (LAS unsigned char*)smem;
    { LAS unsigned long long* pl = (LAS unsigned long long*)(c.ldsl + PARAM_OFF); const int t0 = threadIdx.x;
      if (t0 < 32) pl[t0] = (unsigned long long)p.in[t0]; else if (t0 == 32) pl[32] = (unsigned long long)p.out; else if (t0 == 33) pl[33] = (unsigned long long)p.ws; }
    volatile LAS unsigned* const xst = (volatile LAS unsigned*)(c.ldsl + PARAM_OFF + 448);
    if (threadIdx.x == 64) { xst[0] = 0u; xst[1] = 0u; }
    unsigned* const bar = (unsigned*)(p.ws + WS_BAR);
    const unsigned xcc = xb_xcc_id();
    if (blockIdx.x == 0) for (int i_ = threadIdx.x; i_ < XCD_BAR_WORDS; i_ += NTHR) __hip_atomic_store(bar + i_, 0u, __ATOMIC_RELAXED, __HIP_MEMORY_SCOPE_AGENT);
    __syncthreads();
    const int ph_lo = p.ph_lo, ph_hi = p.ph_hi;
    const int wv = __builtin_amdgcn_readfirstlane(threadIdx.x >> 6);
#ifdef PROBE_SUB
#define RUN(PH, L, PT) if (ph_lo <= (PH) && (PH) < ph_hi) { if (PT == 7) { const unsigned long long tz_ = __builtin_amdgcn_s_memrealtime(); \
      do_phase<L, (PT == 7 ? 13 : PT)>(c, wv); grid.sync(); unsigned long long ta_ = __builtin_amdgcn_s_memrealtime(); do_phase<L, (PT == 7 ? 14 : PT)>(c, wv); grid.sync(); unsigned long long tb_ = __builtin_amdgcn_s_memrealtime(); \
      do_phase<L, (PT == 7 ? 15 : PT)>(c, wv); grid.sync(); unsigned long long tc_ = __builtin_amdgcn_s_memrealtime(); do_phase<L, (PT == 7 ? 16 : PT)>(c, wv); grid.sync(); unsigned long long td_ = __builtin_amdgcn_s_memrealtime(); \
      const unsigned long long w_ = PROBE_SUB == 9 ? 0ull : PROBE_SUB == 0 ? ta_ - tz_ : PROBE_SUB == 1 ? tb_ - ta_ : (PROBE_SUB == 2 ? tc_ - tb_ : (PROBE_SUB == 3 ? td_ - tc_ : (td_ - ta_))); \
      if (blockIdx.x == 0) { while (__builtin_amdgcn_s_memrealtime() - td_ < w_) __builtin_amdgcn_s_sleep(8); } } \
    else { do_phase<L, PT>(c, wv); if (PT == 5) do_phase<L, 12>(c, wv); if ((PH) + 1 < ph_hi) grid.sync(); } }
#elif defined(PROBE_PT)
#define RUN(PH, L, PT) if (ph_lo <= (PH) && (PH) < ph_hi) { const unsigned long long t0_ = __builtin_amdgcn_s_memrealtime(); do_phase<L, PT>(c, wv); if (PT == 5) do_phase<L, 12>(c, wv); grid.sync(); \
    if (PT == PROBE_PT && blockIdx.x == 0) { const unsigned long long t1_ = __builtin_amdgcn_s_memrealtime(); while (__builtin_amdgcn_s_memrealtime() - t1_ < (t1_ - t0_)) __builtin_amdgcn_s_sleep(8); } }
#else
#define RUN(PH, L, PT) if (ph_lo <= (PH) && (PH) < ph_hi) { do_phase<L, PT>(c, wv); if (PT == 5) do_phase<L, 12>(c, wv); if ((PH) + 1 < ph_hi) { if ((PH) == 0) { grid.sync(); if (threadIdx.x == 0) (void)xb_add(&bar[XB_XCNT(xcc)], 1u); } else { int ln_; asm volatile("v_mbcnt_lo_u32_b32 %0, -1, 0\n\tv_mbcnt_hi_u32_b32 %0, -1, %0" : "=v"(ln_)); xcd_barrier(bar, xcc, xst, wv == 0 && ln_ == 0); } } }
#endif
    RUN(0, 0, -1)
    RUN(1, 0, 0) RUN(2, 0, 1) RUN(3, 0, 2) RUN(4, 0, 3) RUN(5, 0, 4) RUN(6, 0, 5) RUN(7, 0, 6) RUN(8, 0, 7) RUN(9, 0, 8) RUN(10, 0, 9) RUN(11, 0, 10) RUN(12, 0, 11)
    RUN(13, 1, 0) RUN(14, 1, 1) RUN(15, 1, 2) RUN(16, 1, 3) RUN(17, 1, 4) RUN(18, 1, 5) RUN(19, 1, 6) RUN(20, 1, 7) RUN(21, 1, 8) RUN(22, 1, 9) RUN(23, 1, 10) RUN(24, 1, 11)
#undef RUN
}

extern "C" void kernel_launch(void* const* d_in, const int* in_sizes, int n_in, void* d_out, int out_size, void* d_ws, size_t ws_size, hipStream_t stream) {
    static int grid = 0;
    if (grid == 0) {
        if (n_in != 32 || ws_size < WS_END) { fprintf(stderr, "kernel_launch: unexpected n_in %d / ws_size %zu (need %zu)\n", n_in, ws_size, (size_t)WS_END); grid = -1; return; }
        int dev = 0, cus = 0, per_cu = 0;
        hipGetDevice(&dev);
        hipDeviceGetAttribute(&cus, hipDeviceAttributeMultiprocessorCount, dev);
        hipFuncSetAttribute((const void*)mega, hipFuncAttributeMaxDynamicSharedMemorySize, LDS_BYTES);
        hipOccupancyMaxActiveBlocksPerMultiprocessor(&per_cu, (const void*)mega, NTHR, LDS_BYTES);
        if (per_cu < 1) per_cu = 1;
        grid = cus;
        (void)hipGetLastError();
    }
    if (grid < 0) return;
    Params p{};
    for (int i = 0; i < 32; ++i) p.in[i] = (const float*)d_in[i];
    p.out = (float*)d_out; p.ws = (unsigned char*)d_ws; p.ph_lo = 0; p.ph_hi = 25;
    void* args[] = {&p};
    hipError_t e = hipLaunchCooperativeKernel((const void*)mega, dim3(grid), dim3(NTHR), args, LDS_BYTES, stream);
    if (e != hipSuccess) fprintf(stderr, "cooperative launch failed: %s (grid %d)\n", hipGetErrorString(e), grid);
}
```
